# Optimizing an MI355X kernel written in HIP

```python
import math
import jax, jax.numpy as jnp
from jax import lax
import numpy as np

D_MODEL = 1024
BATCH = 4
SEQ = 4096
DEPTH = 1

DA_HEADS = 8
DA_HEAD_DIM = D_MODEL // DA_HEADS // 2
DA_V_DIM = 2 * DA_HEAD_DIM
DA_QK_WIDTH = DA_HEADS * 2 * DA_HEAD_DIM
DA_V_WIDTH = DA_HEADS * DA_V_DIM
Q_BLOCK = 128
ML_HEADS = 4
ML_V_DIM = D_MODEL // ML_HEADS
ML_QK_DIM = ML_V_DIM // 2
ML_QK_WIDTH = ML_HEADS * ML_QK_DIM
ML_V_WIDTH = ML_HEADS * ML_V_DIM
ML_CHUNK = 64
CONV_WIDTH = 4
N_BRANCHES = 2
D_FF = 4 * D_MODEL
EPS = 1e-6

SPLIT_SIZES = (DA_QK_WIDTH, DA_QK_WIDTH, DA_V_WIDTH,
               ML_QK_WIDTH, ML_QK_WIDTH, ML_V_WIDTH, 2 * ML_HEADS, ML_V_WIDTH,
               N_BRANCHES * D_MODEL)
D_IN = int(sum(SPLIT_SIZES))
SPLIT_POINTS = [int(s) for s in np.cumsum(SPLIT_SIZES)[:-1]]

kernel_name = "hybrid_gated_diffattn_mlstm_block"


def rms_norm(x, g):
    xf = x.astype(jnp.float32)
    y = xf * lax.rsqrt(jnp.mean(xf * xf, axis=-1, keepdims=True) + EPS)
    return (y * g.astype(jnp.float32)).astype(x.dtype)


def head_rms(x):
    return x * lax.rsqrt(jnp.mean(x * x, axis=-1, keepdims=True) + EPS)


def alibi_slopes(n_heads):
    return 2.0 ** (-8.0 * jnp.arange(1, n_heads + 1, dtype=jnp.float32) / n_heads)


def causal_conv(u, w, b):
    S = u.shape[1]
    up = jnp.pad(u, ((0, 0), (CONV_WIDTH - 1, 0), (0, 0)))
    out = sum(up[:, j:j + S] * w[j] for j in range(CONV_WIDTH))
    return out + b


def diff_attention(q, k, v, lam, lam_init, norm_g):
    B, S, _ = q.shape
    f32 = jnp.float32
    q = q.astype(f32).reshape(B, S, DA_HEADS, 2, DA_HEAD_DIM).transpose(0, 2, 3, 1, 4) * (DA_HEAD_DIM ** -0.5)
    k = k.astype(f32).reshape(B, S, DA_HEADS, 2, DA_HEAD_DIM).transpose(0, 2, 3, 1, 4)
    vf = v.astype(f32).reshape(B, S, DA_HEADS, DA_V_DIM).transpose(0, 2, 1, 3)
    lamf = lam.astype(f32)
    lam_full = jnp.exp(jnp.sum(lamf[0] * lamf[1])) - jnp.exp(jnp.sum(lamf[2] * lamf[3])) + lam_init
    slopes = alibi_slopes(DA_HEADS)
    key_pos = jnp.arange(S)
    n_blocks = S // Q_BLOCK
    q_blocks = q.reshape(B, DA_HEADS, 2, n_blocks, Q_BLOCK, DA_HEAD_DIM).transpose(3, 0, 1, 2, 4, 5)
    starts = jnp.arange(n_blocks) * Q_BLOCK

    def one_block(args):
        qb, start = args
        qpos = start + jnp.arange(Q_BLOCK)
        dist = qpos[:, None] - key_pos[None, :]
        causal = dist >= 0
        bias = -slopes[:, None, None] * dist.astype(f32)
        s = jnp.einsum('bhmqd,bhmkd->bhmqk', qb, k) + bias[None, :, None]
        s = jnp.where(causal, s, -jnp.inf)
        p = jax.nn.softmax(s, axis=-1)
        a = p[:, :, 0] - lam_full * p[:, :, 1]
        return jnp.einsum('bhqk,bhkd->bhqd', a, vf)

    o = lax.map(one_block, (q_blocks, starts))
    o = o.transpose(1, 0, 3, 2, 4).reshape(B, S, DA_HEADS, DA_V_DIM)
    o = head_rms(o) * (1.0 - lam_init)
    o = o.reshape(B, S, DA_V_WIDTH) * norm_g.astype(f32)
    return o.astype(v.dtype)


def mlstm(q, k, v, i_pre, f_pre, o_pre, norm_g):
    B, S, _ = q.shape
    f32 = jnp.float32
    nc = S // ML_CHUNK

    def heads(t, d):
        return t.astype(f32).reshape(B, nc, ML_CHUNK, ML_HEADS, d).transpose(1, 0, 3, 2, 4)

    def gates(t):
        return t.astype(f32).reshape(B, nc, ML_CHUNK, ML_HEADS).transpose(1, 0, 3, 2)

    qc = heads(q, ML_QK_DIM) * (ML_QK_DIM ** -0.5)
    kc = heads(k, ML_QK_DIM)
    vc = heads(v, ML_V_DIM)
    ic = gates(i_pre)
    lfc = gates(jax.nn.log_sigmoid(f_pre.astype(f32)))
    causal = jnp.tril(jnp.ones((ML_CHUNK, ML_CHUNK), dtype=bool))

    def step(carry, xs):
        C, n, m = carry
        q_, k_, v_, ig, lf = xs
        b = jnp.cumsum(lf, axis=-1)
        g = b[..., -1]
        logd = b[..., :, None] - b[..., None, :] + ig[..., None, :]
        logd = jnp.where(causal, logd, -jnp.inf)
        inter = b + m[..., None]
        m_t = jnp.maximum(inter, jnp.max(logd, axis=-1))
        sc = jnp.einsum('bhtd,bhsd->bhts', q_, k_) * jnp.exp(logd - m_t[..., None])
        w_inter = jnp.exp(inter - m_t)
        num = w_inter[..., None] * jnp.einsum('bhtd,bhde->bhte', q_, C) + jnp.einsum('bhts,bhse->bhte', sc, v_)
        den = w_inter * jnp.einsum('bhtd,bhd->bht', q_, n) + jnp.sum(sc, axis=-1)
        h = num / jnp.maximum(jnp.abs(den), jnp.exp(-m_t))[..., None]
        log_w = g[..., None] - b + ig
        m_new = jnp.maximum(g + m, jnp.max(log_w, axis=-1))
        w_s = jnp.exp(log_w - m_new[..., None])
        decay = jnp.exp(g + m - m_new)
        C_new = decay[..., None, None] * C + jnp.einsum('bhs,bhsd,bhse->bhde', w_s, k_, v_)
        n_new = decay[..., None] * n + jnp.einsum('bhs,bhsd->bhd', w_s, k_)
        return (C_new, n_new, m_new), h

    init = (jnp.zeros((B, ML_HEADS, ML_QK_DIM, ML_V_DIM), f32),
            jnp.zeros((B, ML_HEADS, ML_QK_DIM), f32),
            jnp.zeros((B, ML_HEADS), f32))
    _, hs = lax.scan(step, init, (qc, kc, vc, ic, lfc))
    h = hs.transpose(1, 0, 3, 2, 4).reshape(B, S, ML_HEADS, ML_V_DIM)
    h = head_rms(h).reshape(B, S, ML_V_WIDTH) * norm_g.astype(f32)
    h = jax.nn.sigmoid(o_pre.astype(f32)) * h
    return h.astype(v.dtype)


def setup_inputs(seed: int = 0) -> dict:
    key = jax.random.key(seed)
    ks = jax.random.split(key, 20)
    nrm = jax.random.normal
    L = DEPTH
    f_bias = jnp.linspace(3.0, 6.0, ML_HEADS)[None, :] + 0.01 * nrm(ks[3], (L, ML_HEADS))
    i_bias = 0.1 * nrm(ks[4], (L, ML_HEADS))
    return {
        "x": nrm(ks[0], (BATCH, SEQ, D_MODEL), jnp.float32),
        "norm_mix_g": 1.0 + 0.02 * nrm(ks[1], (L, D_MODEL)),
        "w_in": nrm(ks[2], (L, D_MODEL, D_IN)) * D_MODEL ** -0.5,
        "b_gates": jnp.concatenate([i_bias, f_bias], axis=-1),
        "conv_w": nrm(ks[5], (L, CONV_WIDTH, 2 * ML_QK_WIDTH)) * CONV_WIDTH ** -0.5,
        "conv_b": 0.01 * nrm(ks[6], (L, 2 * ML_QK_WIDTH)),
        "lam": 0.1 * nrm(ks[7], (L, 4, DA_HEAD_DIM)),
        "da_norm_g": 1.0 + 0.02 * nrm(ks[8], (L, DA_V_WIDTH)),
        "ml_norm_g": 1.0 + 0.02 * nrm(ks[9], (L, ML_V_WIDTH)),
        "b_merge": 0.01 * nrm(ks[10], (L, N_BRANCHES * D_MODEL)),
        "w_branch_a": nrm(ks[11], (L, DA_V_WIDTH, D_MODEL)) * DA_V_WIDTH ** -0.5,
        "w_branch_m": nrm(ks[12], (L, ML_V_WIDTH, D_MODEL)) * ML_V_WIDTH ** -0.5,
        "w_out": nrm(ks[13], (L, D_MODEL, D_MODEL)) * D_MODEL ** -0.5,
        "norm_mlp_g": 1.0 + 0.02 * nrm(ks[14], (L, D_MODEL)),
        "w_ff1": nrm(ks[15], (L, D_MODEL, D_FF)) * D_MODEL ** -0.5,
        "w_ff2": nrm(ks[16], (L, D_FF, D_MODEL)) * D_FF ** -0.5,
        "norm_final_g": 1.0 + 0.02 * nrm(ks[17], (D_MODEL,)),
    }


def reference(x, norm_mix_g, w_in, b_gates, conv_w, conv_b, lam, da_norm_g, ml_norm_g,
              b_merge, w_branch_a, w_branch_m, w_out, norm_mlp_g, w_ff1, w_ff2, norm_final_g):
    for l in range(DEPTH):
        lam_init = 0.8 - 0.6 * math.exp(-0.3 * l)
        h = rms_norm(x, norm_mix_g[l])
        proj = h @ w_in[l]
        da_q, da_k, da_v, ml_q, ml_k, ml_v, ml_if, ml_o, mg = jnp.split(proj, SPLIT_POINTS, axis=-1)
        a_out = diff_attention(da_q, da_k, da_v, lam[l], lam_init, da_norm_g[l])
        qk = jax.nn.silu(causal_conv(jnp.concatenate([ml_q, ml_k], axis=-1), conv_w[l], conv_b[l]))
        ml_qc, ml_kc = jnp.split(qk, [ML_QK_WIDTH], axis=-1)
        if_pre = ml_if + b_gates[l]
        m_out = mlstm(ml_qc, ml_kc, ml_v, if_pre[..., :ML_HEADS], if_pre[..., ML_HEADS:], ml_o, ml_norm_g[l])
        gate = jax.nn.sigmoid(mg + b_merge[l])
        g_a, g_m = jnp.split(gate, [D_MODEL], axis=-1)
        merged = g_a * (a_out @ w_branch_a[l]) + g_m * (m_out @ w_branch_m[l])
        x = x + merged @ w_out[l]
        hm = rms_norm(x, norm_mlp_g[l])
        x = x + jnp.square(jax.nn.relu(hm @ w_ff1[l])) @ w_ff2[l]
    return rms_norm(x, norm_final_g)
```

```cpp
#include <hip/hip_runtime.h>
#include <hip/hip_cooperative_groups.h>
#include <cstdio>
#include <cstdint>
namespace cg = cooperative_groups;
__device__ __forceinline__ int my_lane() { int l_; asm volatile("v_mbcnt_lo_u32_b32 %0, -1, 0\n\tv_mbcnt_hi_u32_b32 %0, -1, %0" : "=v"(l_)); return l_; }
__device__ __forceinline__ int fresh_tid(int wave_s) { return wave_s * 64 + my_lane(); }
__device__ __forceinline__ float sx(float v, int m) { return __builtin_bit_cast(float, __builtin_amdgcn_ds_bpermute((my_lane() ^ m) << 2, __builtin_bit_cast(int, v))); }
namespace pg8 {
#define PG8_LAS __attribute__((address_space(3)))
typedef unsigned short bf16_t;
typedef short bf16x8 __attribute__((ext_vector_type(8)));
typedef float f32x4 __attribute__((ext_vector_type(4)));
typedef unsigned u32x4 __attribute__((ext_vector_type(4)));
constexpr int BM = 256, BK = 64, HALF = 128, HTB = HALF * BK * 2  , STAGE_BYTES = 8 * HTB, NXCD = 8, WGM = 8;

__host__ __device__ __forceinline__ int lds_byte(int r, int c) { const int st = (r >> 4) * 2 + (c >> 5), rr = r & 15, cc = c & 31, ob = rr * 64 + cc * 2; return st * 1024 + (ob ^ (((ob >> 9) & 1) << 5)); }
__host__ __device__ __forceinline__ void stage_rc(int b, int& R, int& C) { const int st = b / 1024, sb = b % 1024, swz = sb ^ (((sb >> 9) & 1) << 5); R = (st >> 1) * 16 + swz / 64; C = (st & 1) * 32 + (swz % 64) / 2; }
__host__ __device__ __forceinline__ int perm32(int rho) { const int n = rho >> 4, i = rho & 15; return 8 * (i >> 2) + 4 * n + (i & 3); }

struct Unit { int pm, pn; };
struct Gemm { const bf16_t* A; const bf16_t* Bt; int M, N, K; };

struct StaticOrder {
    int nM, nN, nwg, G, c;
    __host__ __device__ void init(int M, int N, int G_, int c_) { nM = M / BM; nN = N / BM; nwg = nM * nN; G = G_; c = c_; }
    __host__ __device__ bool next(int i, Unit& u) const {
        const long L = (long)i * G + c; if (L >= nwg) return false;
        int wgid = (int)L; { const int q = nwg / NXCD, r = nwg % NXCD, xcd = wgid % NXCD, off = wgid / NXCD; wgid = (xcd < r ? xcd * (q + 1) : r * (q + 1) + (xcd - r) * q) + off; }
        const int nig = WGM * nN, gid = wgid / nig, fm = gid * WGM, gsz = (nM - fm) < WGM ? (nM - fm) : WGM;
        u.pm = fm + ((wgid % nig) % gsz); u.pn = (wgid % nig) / gsz; return true;
    }
    __device__ __forceinline__ void a_ready(const Unit&) const {}
    __device__ __forceinline__ void done(const Unit&) const {}
};

__device__ __forceinline__ unsigned cvt_pk_bf16(float lo, float hi) { unsigned r; asm volatile("v_cvt_pk_bf16_f32 %0, %1, %2" : "=v"(r) : "v"(lo), "v"(hi)); return r; }
typedef float f32x2 __attribute__((ext_vector_type(2)));
typedef unsigned u32x2 __attribute__((ext_vector_type(2)));
__device__ __forceinline__ float bf_lo(unsigned w) { return __uint_as_float(w << 16); }
__device__ __forceinline__ float bf_hi(unsigned w) { return __uint_as_float(w & 0xffff0000u); }
__device__ __forceinline__ float sigm(float v) { return __builtin_amdgcn_rcpf(1.f + __expf(-v)); }

struct EpiProj {
    static constexpr bool PERM = true, AFTER_DRAIN = false;
    bf16_t* wsb; bf16_t* outb; size_t stride; const float* bmerge; float scale0; const float* mlng; unsigned* nmax;
    __device__ __forceinline__ void operator()(const f32x4 (&acc)[2][2][4][2], const Unit& u, int wr, int wc, int fr, int fq) const {
        const int row0 = u.pm * BM + wr * 64 + fr; int colt = u.pn * BM; const int t = colt >> 10; colt &= 1023;
        bf16_t* base = (t < 6) ? wsb + (size_t)t * stride : outb + (size_t)(t - 6) * stride;
        const float sc = (t == 0) ? scale0 : 1.f; const bool gate = (t >= 6);
        const int col0 = colt + wc * 32 + 8 * fq;
        f32x4 bv[2][2];
#pragma unroll
        for (int bj = 0; bj < 2; ++bj)
#pragma unroll
            for (int n = 0; n < 2; ++n) bv[bj][n] = gate ? *(const f32x4*)(bmerge + (t - 6) * 1024 + col0 + bj * HALF + 4 * n) : (f32x4){0.f, 0.f, 0.f, 0.f};
        float pmax[2] = {0.f, 0.f};
#pragma unroll
        for (int ai = 0; ai < 2; ++ai)
#pragma unroll
            for (int m = 0; m < 4; ++m) { bf16_t* rowp = base + (size_t)(row0 + ai * HALF + m * 16) * 1024 + col0;
#pragma unroll
                for (int bj = 0; bj < 2; ++bj) { f32x4 v0 = acc[ai][bj][m][0] + bv[bj][0], v1 = acc[ai][bj][m][1] + bv[bj][1];
                    if (gate || t == 5) { v0 = (f32x4){sigm(v0[0]), sigm(v0[1]), sigm(v0[2]), sigm(v0[3])}; v1 = (f32x4){sigm(v1[0]), sigm(v1[1]), sigm(v1[2]), sigm(v1[3])}; }
                    if (t == 5) { v0 = v0 * *(const f32x4*)(mlng + col0 + bj * HALF); v1 = v1 * *(const f32x4*)(mlng + col0 + bj * HALF + 4); }
                    v0 = v0 * sc; v1 = v1 * sc; u32x4 w; w.x = cvt_pk_bf16(v0[0], v0[1]); w.y = cvt_pk_bf16(v0[2], v0[3]); w.z = cvt_pk_bf16(v1[0], v1[1]); w.w = cvt_pk_bf16(v1[2], v1[3]);
                    *(u32x4*)(rowp + bj * HALF) = w;
                    if (t < 2) { float ss = (v0[0] * v0[0] + v0[1] * v0[1]) + (v0[2] * v0[2] + v0[3] * v0[3]) + (v1[0] * v1[0] + v1[1] * v1[1]) + (v1[2] * v1[2] + v1[3] * v1[3]);
                        ss += sx(ss, 16); ss += sx(ss, 32); pmax[bj] = fmaxf(pmax[bj], ss); } } }
        if (t < 2) {
#pragma unroll
            for (int bj = 0; bj < 2; ++bj) { float p = pmax[bj]; p = fmaxf(p, sx(p, 1)); p = fmaxf(p, sx(p, 2)); p = fmaxf(p, sx(p, 4)); p = fmaxf(p, sx(p, 8));
                if (fr == 0 && fq == 0) { const int bb_ = (u.pm * BM) >> 12, hm_ = (colt >> 6) + 2 * bj + (wc >> 1); atomicMax(nmax + (((bb_ * 16 + hm_) * 2 + t) * 2 + (wc & 1)), __float_as_uint(p)); } }
        }
    }
};
template <bool ADD> struct EpiGate {
    static constexpr bool PERM = true, AFTER_DRAIN = false;
    const bf16_t* g; const bf16_t* prev; bf16_t* O;
    __device__ __forceinline__ void operator()(const f32x4 (&acc)[2][2][4][2], const Unit& u, int wr, int wc, int fr, int fq) const {
        const int row0 = u.pm * BM + wr * 64 + fr; const int col0 = u.pn * BM + wc * 32 + 8 * fq;
#pragma unroll
        for (int ai = 0; ai < 2; ++ai) {
            u32x4 gw[4][2], pw[4][2];
#pragma unroll
            for (int m = 0; m < 4; ++m)
#pragma unroll
                for (int bj = 0; bj < 2; ++bj) { const size_t off = (size_t)(row0 + ai * HALF + m * 16) * 1024 + col0 + bj * HALF;
                    gw[m][bj] = *(const u32x4*)(g + off); if (ADD) pw[m][bj] = *(const u32x4*)(prev + off); }
            asm volatile("" ::: "memory");
#pragma unroll
            for (int m = 0; m < 4; ++m)
#pragma unroll
                for (int bj = 0; bj < 2; ++bj) { const size_t off = (size_t)(row0 + ai * HALF + m * 16) * 1024 + col0 + bj * HALF; const u32x4 gq = gw[m][bj];
                    f32x4 v0 = acc[ai][bj][m][0], v1 = acc[ai][bj][m][1];
                    v0 = v0 * (f32x4){bf_lo(gq.x), bf_hi(gq.x), bf_lo(gq.y), bf_hi(gq.y)}; v1 = v1 * (f32x4){bf_lo(gq.z), bf_hi(gq.z), bf_lo(gq.w), bf_hi(gq.w)};
                    if (ADD) { const u32x4 pq = pw[m][bj];
                        v0 = v0 + (f32x4){bf_lo(pq.x), bf_hi(pq.x), bf_lo(pq.y), bf_hi(pq.y)}; v1 = v1 + (f32x4){bf_lo(pq.z), bf_hi(pq.z), bf_lo(pq.w), bf_hi(pq.w)}; }
                    u32x4 w; w.x = cvt_pk_bf16(v0[0], v0[1]); w.y = cvt_pk_bf16(v0[2], v0[3]); w.z = cvt_pk_bf16(v1[0], v1[1]); w.w = cvt_pk_bf16(v1[2], v1[3]);
                    *(u32x4*)(O + off) = w; }
            asm volatile("" ::: "memory");
        }
    }
};
struct EpiRes {
    static constexpr bool PERM = false, AFTER_DRAIN = false;
    const float* base; float* out; bf16_t* outb; float* rsq;
    __device__ __forceinline__ void operator()(const f32x4 (&acc)[2][2][4][2], const Unit& u, int wr, int wc, int fr, int fq) const {
        const int col0 = u.pn * BM + wc * 32 + 4 * fq;
#pragma unroll
        for (int ai = 0; ai < 2; ++ai) {
            f32x4 bs[4][2][2];
#pragma unroll
            for (int m = 0; m < 4; ++m) { const size_t off = (size_t)(u.pm * BM + ai * HALF + wr * 64 + m * 16 + fr) * 1024 + col0;
#pragma unroll
                for (int bj = 0; bj < 2; ++bj)
#pragma unroll
                    for (int n = 0; n < 2; ++n) bs[m][bj][n] = *(const f32x4*)(base + off + bj * HALF + n * 16); }
            asm volatile("" ::: "memory");
#pragma unroll
            for (int m = 0; m < 4; ++m) { const int row = u.pm * BM + ai * HALF + wr * 64 + m * 16 + fr; const size_t off = (size_t)row * 1024 + col0; float ss = 0.f;
#pragma unroll
                for (int bj = 0; bj < 2; ++bj)
#pragma unroll
                    for (int n = 0; n < 2; ++n) { const f32x4 v = bs[m][bj][n] + acc[ai][bj][m][n];
                        if (out) *(f32x4*)(out + off + bj * HALF + n * 16) = v;
                        if (outb) { u32x2 w; w.x = cvt_pk_bf16(v[0], v[1]); w.y = cvt_pk_bf16(v[2], v[3]); *(u32x2*)(outb + off + bj * HALF + n * 16) = w; }
                        ss += (v[0] * v[0] + v[1] * v[1]) + (v[2] * v[2] + v[3] * v[3]); }
                ss += sx(ss, 16); ss += sx(ss, 32);
                if (fq == 0) atomicAdd(rsq + row, ss); }
            asm volatile("" ::: "memory");
        }
    }
};
struct EpiFinal {
    static constexpr bool PERM = false, AFTER_DRAIN = true;
    const bf16_t* base; float* out; const float* gain; float* xbuf; unsigned* cnt; float eps;
    __device__ __forceinline__ void fused(f32x4 (&acc)[2][2][4][2], const Unit& u, int wr, int wc, int fr, int fq, PG8_LAS unsigned char* lds, int wid, int lane) const {
        PG8_LAS float* P = (PG8_LAS float*)lds;
        PG8_LAS float* S = (PG8_LAS float*)(lds + 4096);
        PG8_LAS unsigned* flag = (PG8_LAS unsigned*)(lds + 5120);
        const int col0 = u.pn * BM + wc * 32 + 4 * fq;
#pragma unroll
        for (int ai = 0; ai < 2; ++ai)
#pragma unroll
            for (int m = 0; m < 4; ++m) { const int rl = ai * HALF + wr * 64 + m * 16 + fr; const size_t off = (size_t)(u.pm * BM + rl) * 1024 + col0; float ss = 0.f;
#pragma unroll
                for (int bj = 0; bj < 2; ++bj)
#pragma unroll
                    for (int n = 0; n < 2; ++n) { const u32x2 bw = *(const u32x2*)(base + off + bj * HALF + n * 16); const f32x4 bs = {bf_lo(bw.x), bf_hi(bw.x), bf_lo(bw.y), bf_hi(bw.y)}; const f32x4 v = bs + acc[ai][bj][m][n]; acc[ai][bj][m][n] = v;
                        ss += (v[0] * v[0] + v[1] * v[1]) + (v[2] * v[2] + v[3] * v[3]); }
                ss += sx(ss, 16); ss += sx(ss, 32);
                if (fq == 0) P[rl * 4 + wc] = ss;
                if (m & 1) asm volatile("" ::: "memory"); }
        asm volatile("s_waitcnt lgkmcnt(0)" ::: "memory"); __builtin_amdgcn_s_barrier(); asm volatile("" ::: "memory");
        const int row = wid * 32 + (lane & 31);
        if (lane < 32) { const f32x4 p4 = *(PG8_LAS const f32x4*)(P + row * 4); const float s = (p4[0] + p4[1]) + (p4[2] + p4[3]);
            __hip_atomic_store(xbuf + (size_t)(u.pm * BM + row) * 4 + u.pn, s, __ATOMIC_RELAXED, __HIP_MEMORY_SCOPE_AGENT); }
        asm volatile("s_waitcnt vmcnt(0)" ::: "memory");
        if (lane == 0) __hip_atomic_fetch_add(cnt + 64 * u.pm, 1u, __ATOMIC_RELAXED, __HIP_MEMORY_SCOPE_AGENT);
        if (wid == 0) {
            unsigned sp = 0;
            while ((unsigned)__builtin_amdgcn_readfirstlane(__hip_atomic_load(cnt + 64 * u.pm, __ATOMIC_RELAXED, __HIP_MEMORY_SCOPE_AGENT)) < 32u && ++sp < (1u << 22)) __builtin_amdgcn_s_sleep(2);
            __builtin_amdgcn_fence(__ATOMIC_ACQUIRE, "agent");
            if (lane == 0) flag[0] = 1u;
        }
        asm volatile("s_waitcnt vmcnt(0) lgkmcnt(0)" ::: "memory"); __builtin_amdgcn_s_barrier(); asm volatile("" ::: "memory");
        if (lane < 32) { const float* sl = xbuf + (size_t)(u.pm * BM + row) * 4; float t = 0.f;
#pragma unroll
            for (int q = 0; q < 4; ++q) t += __hip_atomic_load(sl + q, __ATOMIC_RELAXED, __HIP_MEMORY_SCOPE_AGENT);
            S[row] = __builtin_amdgcn_rsqf(t * (1.f / 1024.f) + eps); }
        asm volatile("s_waitcnt lgkmcnt(0)" ::: "memory"); __builtin_amdgcn_s_barrier(); asm volatile("" ::: "memory");
        f32x4 gv[2][2];
#pragma unroll
        for (int bj = 0; bj < 2; ++bj)
#pragma unroll
            for (int n = 0; n < 2; ++n) gv[bj][n] = *(const f32x4*)(gain + col0 + bj * HALF + n * 16);
#pragma unroll
        for (int ai = 0; ai < 2; ++ai)
#pragma unroll
            for (int m = 0; m < 4; ++m) { const int rl = ai * HALF + wr * 64 + m * 16 + fr; const float rs = S[rl]; const size_t off = (size_t)(u.pm * BM + rl) * 1024 + col0;
#pragma unroll
                for (int bj = 0; bj < 2; ++bj)
#pragma unroll
                    for (int n = 0; n < 2; ++n) *(f32x4*)(out + off + bj * HALF + n * 16) = acc[ai][bj][m][n] * rs * gv[bj][n]; }
    }
};
struct EpiFF1 {
    static constexpr bool PERM = true, AFTER_DRAIN = false;
    bf16_t* O; const float* rsq; float eps;
    __device__ __forceinline__ void operator()(const f32x4 (&acc)[2][2][4][2], const Unit& u, int wr, int wc, int fr, int fq) const {
        const int row0 = u.pm * BM + wr * 64 + fr; const int col0 = u.pn * BM + wc * 32 + 8 * fq;
#pragma unroll
        for (int ai = 0; ai < 2; ++ai)
#pragma unroll
            for (int m = 0; m < 4; ++m) { const int row = row0 + ai * HALF + m * 16; const float rs = __builtin_amdgcn_rsqf(rsq[row] * (1.f / 1024.f) + eps);
                bf16_t* rowp = O + (size_t)row * 4096 + col0;
#pragma unroll
                for (int bj = 0; bj < 2; ++bj) { f32x4 v0 = acc[ai][bj][m][0] * rs, v1 = acc[ai][bj][m][1] * rs;
#pragma unroll
                    for (int i = 0; i < 4; ++i) { float a = fmaxf(v0[i], 0.f), b = fmaxf(v1[i], 0.f); v0[i] = a * a; v1[i] = b * b; }
                    u32x4 w; w.x = cvt_pk_bf16(v0[0], v0[1]); w.y = cvt_pk_bf16(v0[2], v0[3]); w.z = cvt_pk_bf16(v1[0], v1[1]); w.w = cvt_pk_bf16(v1[2], v1[3]);
                    *(u32x4*)(rowp + bj * HALF) = w; } }
    }
};
template <class Epi, class Sched, bool ALIGN_EPI = false, bool SP2 = false>
__device__ __forceinline__ void gemm_phase(PG8_LAS unsigned char* lds, const Gemm g, const Sched& S, const Epi& E, const int wave_s) {
    const int tid = fresh_tid(wave_s), wid = __builtin_amdgcn_readfirstlane(tid >> 6), lane = tid & 63, wr = wid >> 2, wc = wid & 3, fr = lane & 15, fq = lane >> 4;
    const int K = g.K, nt = K / BK;
    unsigned voffA[2], voffB[2];
#pragma unroll
    for (int i = 0; i < 2; ++i) { int R, C; stage_rc(tid * 16 + i * 8192, R, C); const int Rb = Epi::PERM ? ((R & ~31) + perm32(R & 31)) : R;
        voffA[i] = (unsigned)(R * K + C) * 2u; voffB[i] = (unsigned)(Rb * K + C) * 2u; }
    const size_t kstep = (size_t)(BK * 2);
    const size_t hstep = (size_t)HALF * K * 2;
    const size_t tstep = 2 * hstep;
    const unsigned ldsw = (unsigned)wid * 1024u;
    const int aoff = lds_byte(wr * 64 + fr, fq * 8), boff = lds_byte(wc * 32 + fr, fq * 8);
#define PG8_SA(b, h) (((b) * 2 + (h)) * HTB)
#define PG8_SB(b, h) ((4 + (b) * 2 + (h)) * HTB)
#define PG8_STAGE(bufoff, gbase, voff) do { _Pragma("unroll") for (int _i = 0; _i < 2; ++_i) \
        __builtin_amdgcn_global_load_lds((const unsigned*)((const char*)(gbase) + (voff)[_i]), (PG8_LAS unsigned*)(lds + (bufoff) + ldsw + _i * 8192), 16, 0, 0); } while (0)
#define PG8_LDA(dst, b, h) do { _Pragma("unroll") for (int m = 0; m < 4; ++m) _Pragma("unroll") for (int k = 0; k < 2; ++k) dst[m][k] = *(const PG8_LAS bf16x8*)(lds + PG8_SA(b, h) + aoff + m * 2048 + k * 1024); } while (0)
#define PG8_LDB(dst, b, h) do { _Pragma("unroll") for (int n = 0; n < 2; ++n) _Pragma("unroll") for (int k = 0; k < 2; ++k) dst[n][k] = *(const PG8_LAS bf16x8*)(lds + PG8_SB(b, h) + boff + n * 2048 + k * 1024); } while (0)
#define PG8_MMA(ai, bj, At, Bt) do { __builtin_amdgcn_s_setprio(1); _Pragma("unroll") for (int m = 0; m < 4; ++m) _Pragma("unroll") for (int n = 0; n < 2; ++n) _Pragma("unroll") for (int k = 0; k < 2; ++k) \
        acc[ai][bj][m][n] = __builtin_amdgcn_mfma_f32_16x16x32_bf16(Bt[n][k], At[m][k], acc[ai][bj][m][n], 0, 0, 0); __builtin_amdgcn_s_setprio(0); } while (0)
#define PG8_WAIT_V(n) asm volatile("s_waitcnt vmcnt(" #n ")" ::: "memory")
#define PG8_WAIT_L(n) asm volatile("s_waitcnt lgkmcnt(" #n ")" ::: "memory")
#define PG8_BAR __builtin_amdgcn_s_barrier()
#define PG8_SCHED __builtin_amdgcn_sched_barrier(0)
    Unit cur, nxt; int ui = 0;
    if (!S.next(0, cur)) return;
    f32x4 acc[2][2][4][2];
#pragma unroll
    for (int a = 0; a < 2; ++a)
#pragma unroll
        for (int b = 0; b < 2; ++b)
#pragma unroll
            for (int m = 0; m < 4; ++m)
#pragma unroll
                for (int n = 0; n < 2; ++n) acc[a][b][m][n] = (f32x4){0.f, 0.f, 0.f, 0.f};
    bf16x8 At[4][2], B0[2][2], B1[2][2];
    const char* cA = (const char*)g.A + (size_t)cur.pm * tstep; const char* cB = (const char*)g.Bt + (size_t)cur.pn * tstep;
    S.a_ready(cur);
    if constexpr (SP2) {
        PG8_STAGE(PG8_SB(0, 0), cB, voffB); PG8_STAGE(PG8_SB(0, 1), cB + hstep, voffB); PG8_STAGE(PG8_SA(0, 0), cA, voffA); PG8_STAGE(PG8_SA(0, 1), cA + hstep, voffA);
        if (wr == 1) PG8_BAR;
        PG8_WAIT_V(2); PG8_BAR;
        PG8_STAGE(PG8_SB(1, 0), cB + kstep, voffB); PG8_STAGE(PG8_SA(1, 0), cA + kstep, voffA); PG8_STAGE(PG8_SB(1, 1), cB + hstep + kstep, voffB);
        PG8_WAIT_V(6); PG8_BAR;
    } else {
        PG8_STAGE(PG8_SB(0, 0), cB, voffB); PG8_STAGE(PG8_SA(0, 0), cA, voffA); PG8_STAGE(PG8_SB(0, 1), cB + hstep, voffB); PG8_STAGE(PG8_SA(0, 1), cA + hstep, voffA);
        if (wr == 1) PG8_BAR;
        PG8_WAIT_V(4); PG8_BAR;
        PG8_STAGE(PG8_SB(1, 0), cB + kstep, voffB); PG8_STAGE(PG8_SA(1, 0), cA + kstep, voffA); PG8_STAGE(PG8_SB(1, 1), cB + hstep + kstep, voffB);
        PG8_WAIT_V(6); PG8_BAR;
    }
    for (;;) {
        const bool has_next = S.next(ui + 1, nxt);
        const char* nA = has_next ? (const char*)g.A + (size_t)nxt.pm * tstep : cA; const char* nB = has_next ? (const char*)g.Bt + (size_t)nxt.pn * tstep : cB;
        for (int t = 0; t < nt; t += 2) {
            const bool last = (t == nt - 2);
            const char* a1 = cA + (size_t)(t + 1) * kstep;
            const char* a2 = last ? nA : cA + (size_t)(t + 2) * kstep; const char* b2 = last ? nB : cB + (size_t)(t + 2) * kstep;
            const char* a3 = a2 + kstep; const char* b3 = b2 + kstep;
            if (last && has_next) S.a_ready(nxt);
            if constexpr (SP2) {
            PG8_LDB(B0, 0, 0); PG8_LDB(B1, 0, 1); PG8_SCHED; PG8_LDA(At, 0, 0); PG8_STAGE(PG8_SA(1, 1), a1 + hstep, voffA);
            PG8_WAIT_V(8); PG8_WAIT_L(0); PG8_BAR; PG8_MMA(0, 0, At, B0); PG8_MMA(0, 1, At, B1); PG8_BAR; PG8_SCHED;
            PG8_LDA(At, 0, 1); PG8_STAGE(PG8_SB(0, 0), b2, voffB); PG8_STAGE(PG8_SB(0, 1), b2 + hstep, voffB); PG8_STAGE(PG8_SA(0, 0), a2, voffA);
            PG8_WAIT_V(8); PG8_WAIT_L(0); PG8_BAR; PG8_MMA(1, 0, At, B0); PG8_MMA(1, 1, At, B1); PG8_BAR; PG8_SCHED;
            PG8_LDB(B0, 1, 0); PG8_LDB(B1, 1, 1); PG8_SCHED; PG8_LDA(At, 1, 0); PG8_STAGE(PG8_SA(0, 1), a2 + hstep, voffA);
            PG8_WAIT_V(8); PG8_WAIT_L(0); PG8_BAR; PG8_MMA(0, 0, At, B0); PG8_MMA(0, 1, At, B1); PG8_BAR; PG8_SCHED;
            PG8_LDA(At, 1, 1); PG8_STAGE(PG8_SB(1, 0), b3, voffB); PG8_STAGE(PG8_SB(1, 1), b3 + hstep, voffB); PG8_STAGE(PG8_SA(1, 0), a3, voffA);
            PG8_WAIT_V(8); PG8_WAIT_L(0); PG8_BAR; PG8_MMA(1, 0, At, B0); PG8_MMA(1, 1, At, B1); PG8_BAR; PG8_SCHED;
            } else {
            PG8_LDB(B0, 0, 0); PG8_SCHED; PG8_LDA(At, 0, 0); PG8_STAGE(PG8_SA(1, 1), a1 + hstep, voffA);
            PG8_WAIT_L(8); PG8_BAR; PG8_WAIT_L(0); PG8_MMA(0, 0, At, B0); PG8_BAR; PG8_SCHED;
            PG8_LDB(B1, 0, 1); PG8_STAGE(PG8_SB(0, 0), b2, voffB);
            PG8_BAR; PG8_WAIT_L(0); PG8_MMA(0, 1, At, B1); PG8_BAR;
            PG8_LDA(At, 0, 1); PG8_STAGE(PG8_SA(0, 0), a2, voffA);
            PG8_BAR; PG8_WAIT_L(0); PG8_MMA(1, 0, At, B0); PG8_BAR; PG8_SCHED;
            PG8_STAGE(PG8_SB(0, 1), b2 + hstep, voffB);
            PG8_WAIT_V(6); PG8_BAR; PG8_MMA(1, 1, At, B1); PG8_BAR;
            PG8_LDB(B0, 1, 0); PG8_SCHED; PG8_LDA(At, 1, 0); PG8_STAGE(PG8_SA(0, 1), a2 + hstep, voffA);
            PG8_WAIT_L(8); PG8_BAR; PG8_WAIT_L(0); PG8_MMA(0, 0, At, B0); PG8_BAR; PG8_SCHED;
            PG8_LDB(B1, 1, 1); PG8_STAGE(PG8_SB(1, 0), b3, voffB);
            PG8_BAR; PG8_WAIT_L(0); PG8_MMA(0, 1, At, B1); PG8_BAR;
            PG8_LDA(At, 1, 1); PG8_STAGE(PG8_SA(1, 0), a3, voffA);
            PG8_BAR; PG8_WAIT_L(0); PG8_MMA(1, 0, At, B0); PG8_BAR; PG8_SCHED;
            PG8_STAGE(PG8_SB(1, 1), b3 + hstep, voffB);
            PG8_WAIT_V(6); PG8_BAR; PG8_MMA(1, 1, At, B1); PG8_BAR;
            }
        }
        if constexpr (ALIGN_EPI) { if (wr == 0) PG8_BAR; }
        if constexpr (!Epi::AFTER_DRAIN) { E(acc, cur, wr, wc, fr, fq); S.done(cur); }
        if (!has_next) break;
#pragma unroll
        for (int a = 0; a < 2; ++a)
#pragma unroll
            for (int b = 0; b < 2; ++b)
#pragma unroll
                for (int m = 0; m < 4; ++m)
#pragma unroll
                    for (int n = 0; n < 2; ++n) acc[a][b][m][n] = (f32x4){0.f, 0.f, 0.f, 0.f};
        cur = nxt; cA = nA; cB = nB; ++ui;
        if constexpr (ALIGN_EPI) { if (wr == 1) PG8_BAR; }
    }
    PG8_WAIT_V(0);
    if constexpr (!ALIGN_EPI) { if (wr == 0) PG8_BAR; }
    PG8_BAR;
    if constexpr (Epi::AFTER_DRAIN) { E.fused(acc, cur, wr, wc, fr, fq, lds, wid, lane); S.done(cur); }
#undef PG8_SA
#undef PG8_SB
#undef PG8_STAGE
#undef PG8_LDA
#undef PG8_LDB
#undef PG8_MMA
#undef PG8_WAIT_V
#undef PG8_WAIT_L
#undef PG8_BAR
#undef PG8_SCHED
}
}

#ifndef PG8_SP2
#define PG8_SP2 true
#endif
#ifndef PG8_ALIGN
#define PG8_ALIGN true
#endif
#include <hip/hip_bf16.h>
#include <cmath>
#include <hip/hip_bf16.h>
#include <cmath>
namespace attn_body {
using bf16=__hip_bfloat16;
using bf16x8=__attribute__((ext_vector_type(8)))short;
using s16x4=__attribute__((ext_vector_type(4)))short;
using f32x16=__attribute__((ext_vector_type(16)))float;
using u32x4=__attribute__((ext_vector_type(4)))unsigned;
constexpr int BATCH=4,NHEAD=16,SEQ=4096,D=64,DM=NHEAD*D;
constexpr int NW=8,QBLK=32,QB=QBLK*NW,KVBLK=64,NQB=SEQ/QB;
constexpr int ATTN_PITCH=DM, ATTN_UNIT_ROWS=QB;
__device__ __forceinline__ int crow(int r,int hi){return (r&3)+8*(r>>2)+4*hi;}
#define SBAR() __builtin_amdgcn_sched_barrier(0)
__device__ __forceinline__ void cmask(f32x16&p0,f32x16&p1,int jb,int qrel,int hi){
  const float NEG=-INFINITY; int kb=64*jb+4*hi;
  #pragma unroll
  for(int r=0;r<16;++r){int kv=kb+(r&3)+8*(r>>2); if(kv>qrel)p0[r]=NEG; if(kv+32>qrel)p1[r]=NEG;}
}

constexpr int NSLOT=3, SLOTB=8192;
constexpr int VSLOTB=2*SLOTB;
constexpr int LDS_K=0, LDS_V=NSLOT*SLOTB, LDS_WS=LDS_V+NSLOT*VSLOTB, LDS_OST=LDS_WS+NW*64*4, LDS_Q=LDS_OST+NW*4096, LDS_BYTES=LDS_Q+NW*4096;
constexpr float C2=0.125f*1.4426950408889634f;
__device__ __forceinline__ void glds16(const void*gsrc,unsigned lds_dst){unsigned keep;
  asm volatile("s_mov_b32 %0, m0\n\ts_mov_b32 m0, %2\n\ts_nop 0\n\tglobal_load_lds_dwordx4 %1, off\n\ts_mov_b32 m0, %0":"=&s"(keep):"v"(gsrc),"s"(lds_dst):"memory");}
__device__ __forceinline__ float max3f(float a,float b,float c){float r;asm("v_max3_f32 %0, %1, %2, %3":"=v"(r):"v"(a),"v"(b),"v"(c));return r;}
__device__ __forceinline__ float max2f(float a,float b){float r;asm("v_max_f32_e32 %0, %1, %2":"=v"(r):"v"(a),"v"(b));return r;}
__device__ __forceinline__ float fadd_s(float a,float b){float r;asm("v_add_f32_e32 %0, %1, %2":"=v"(r):"v"(a),"v"(b));return r;}
__device__ __forceinline__ float fsub_s(float a,float b){float r;asm("v_sub_f32_e32 %0, %1, %2":"=v"(r):"v"(a),"v"(b));return r;}
typedef float f32x2_t __attribute__((ext_vector_type(2))); typedef __bf16 bf16x2_t __attribute__((ext_vector_type(2)));
__device__ __forceinline__ unsigned cvtpk_s(float lo,float hi){f32x2_t v={lo,hi};bf16x2_t b=__builtin_convertvector(v,bf16x2_t);return __builtin_bit_cast(unsigned,b);}
#define WAIT_BAR(N) asm volatile("s_waitcnt vmcnt(" #N ") lgkmcnt(0)\n\ts_barrier":::"memory")

__device__ __forceinline__ void qkt(f32x16&p0,f32x16&p1,const char*Kslot,const bf16x8*qr,const f32x16&negm,int r32,int hi){
  const char*kb=Kslot+hi*1024+r32*16;
  #pragma unroll
  for(int d0=0;d0<4;++d0){
    const bf16x8 b0=*reinterpret_cast<const bf16x8*>(kb+d0*2048);
    const bf16x8 b1=*reinterpret_cast<const bf16x8*>(kb+d0*2048+512);
    if(d0==0){p0=__builtin_amdgcn_mfma_f32_32x32x16_bf16(b0,qr[0],negm,0,0,0);p1=__builtin_amdgcn_mfma_f32_32x32x16_bf16(b1,qr[0],negm,0,0,0);}
    else{p0=__builtin_amdgcn_mfma_f32_32x32x16_bf16(b0,qr[d0],p0,0,0,0);p1=__builtin_amdgcn_mfma_f32_32x32x16_bf16(b1,qr[d0],p1,0,0,0);}}
}
typedef __attribute__((address_space(3))) const char* lds_cptr;
typedef short v4i16_t __attribute__((ext_vector_type(4)));
__device__ __forceinline__ void kload8(bf16x8*kf,lds_cptr kp){
  kf[0]=*(const __attribute__((address_space(3))) bf16x8*)(kp);      kf[1]=*(const __attribute__((address_space(3))) bf16x8*)(kp+512);
  kf[2]=*(const __attribute__((address_space(3))) bf16x8*)(kp+2048); kf[3]=*(const __attribute__((address_space(3))) bf16x8*)(kp+2560);
  kf[4]=*(const __attribute__((address_space(3))) bf16x8*)(kp+4096); kf[5]=*(const __attribute__((address_space(3))) bf16x8*)(kp+4608);
  kf[6]=*(const __attribute__((address_space(3))) bf16x8*)(kp+6144); kf[7]=*(const __attribute__((address_space(3))) bf16x8*)(kp+6656);
}
__device__ __forceinline__ void kload2(bf16x8*kf,lds_cptr kp,int j){ kf[2*j]=*(const __attribute__((address_space(3))) bf16x8*)(kp+j*2048); kf[2*j+1]=*(const __attribute__((address_space(3))) bf16x8*)(kp+j*2048+512); }
__device__ __forceinline__ s16x4 vtr(lds_cptr p){ return __builtin_bit_cast(s16x4,__builtin_amdgcn_ds_read_tr16_b64_v4i16((__attribute__((address_space(3))) v4i16_t*)p)); }
__device__ __forceinline__ float rowmax(const f32x16&p0,const f32x16&p1){
  float a=max3f(p0[0],p0[1],p1[0]),b=max3f(p0[2],p0[3],p1[1]);a=max3f(a,p1[2],p1[3]);
  #pragma unroll
  for(int r=4;r<16;r+=4){a=max3f(a,p0[r],p0[r+1]);b=max3f(b,p0[r+2],p0[r+3]);a=max3f(a,p1[r],p1[r+1]);b=max3f(b,p1[r+2],p1[r+3]);}
  const float m=max2f(a,b);
  auto rr=__builtin_amdgcn_permlane32_swap(__float_as_uint(m),__float_as_uint(m),false,false);
  return max2f(__uint_as_float(rr[0]),__uint_as_float(rr[1]));
}
__device__ __forceinline__ void pv(f32x16*o,int vb,bf16x8 pa0,bf16x8 pa1,bf16x8 pa2,bf16x8 pa3){
  #pragma unroll
  for(int d0=0;d0<4;++d0){s16x4 lo[4],hi[4];
    #pragma unroll
    for(int ks=0;ks<4;++ks){
      asm volatile("ds_read_b64_tr_b16 %0,%1 offset:%c2":"=&v"(lo[ks]):"v"(vb),"i"(d0*4096+ks*1024):"memory");
      asm volatile("ds_read_b64_tr_b16 %0,%1 offset:%c2":"=&v"(hi[ks]):"v"(vb),"i"(d0*4096+ks*1024+512):"memory");}
    asm volatile("s_waitcnt lgkmcnt(0)":::"memory");SBAR();
    #define PK(k) (bf16x8){lo[k][0],lo[k][1],lo[k][2],lo[k][3],hi[k][0],hi[k][1],hi[k][2],hi[k][3]}
    o[d0]=__builtin_amdgcn_mfma_f32_32x32x16_bf16(pa0,PK(0),o[d0],0,0,0);
    o[d0]=__builtin_amdgcn_mfma_f32_32x32x16_bf16(pa1,PK(1),o[d0],0,0,0);
    o[d0]=__builtin_amdgcn_mfma_f32_32x32x16_bf16(pa2,PK(2),o[d0],0,0,0);
    o[d0]=__builtin_amdgcn_mfma_f32_32x32x16_bf16(pa3,PK(3),o[d0],0,0,0);
    #undef PK
  }
}

#ifndef ATTN_STORE16
#define ATTN_STORE16(p,v) (*(u32x4*)(p)=(v))
#endif
template<int THRL> __device__ __forceinline__ void attn_unit(int b,int h,int vcol,int qb,int t0,float sl2,const bf16*Q,const bf16*K,const bf16*V,bf16*Ob,int opitch,char*shm,const int wave_s){
  const int tid=fresh_tid(wave_s),lane=tid&63,r32=lane&31,hi=lane>>5; const int wid=__builtin_amdgcn_readfirstlane(tid>>6);
  const long rowbase=(long)b*SEQ; const int q0=qb*QB;
  const bf16*Qw=Q+(rowbase+q0+wid*QBLK)*DM+h*D;
  const bf16*Kh=K+(rowbase+(long)t0*KVBLK)*DM+h*D,*Vh=V+(rowbase+(long)t0*KVBLK)*DM+vcol; const int q0e=q0-t0*KVBLK;
  const unsigned lds0=(unsigned)(uintptr_t)shm;
  float*wsf=(float*)(shm+LDS_WS)+wid*64;
  const bf16*ksrc=Kh+(long)lane*DM+wid*8;
  const bf16*vsrc=Vh+(long)(16*(wid&3)+(lane>>2))*DM+(wid>>2)*32+(lane&3)*8;
  const unsigned kdst=lds0+LDS_K+wid*1024, vdst=lds0+LDS_V+wid*1024;
  #define DMA_K(t,slot) glds16(ksrc+(long)(t)*KVBLK*DM,(unsigned)__builtin_amdgcn_readfirstlane(kdst+(slot)))
  #define DMA_V(t,slot) do{ glds16(vsrc+(long)(t)*KVBLK*DM,(unsigned)__builtin_amdgcn_readfirstlane(vdst+2*(slot))); glds16(vsrc+64+(long)(t)*KVBLK*DM,(unsigned)__builtin_amdgcn_readfirstlane(vdst+8192+2*(slot))); }while(0)
  const int vb0=(int)(lds0+LDS_V)+((lane>>4)&1)*32+(lane&3)*8+(4*hi+((lane&15)>>2))*64;
  const char*Kbase=shm+LDS_K; bf16x8 kf[8];
  const lds_cptr shm3=(lds_cptr)shm; const lds_cptr kp0=shm3+LDS_K+hi*1024+r32*16; const lds_cptr vp0=shm3+LDS_V+((lane>>4)&1)*32+(lane&3)*8+(4*hi+((lane&15)>>2))*64;
  const int NT=(q0+QB)/KVBLK-t0;
  DMA_K(0,0);DMA_V(0,0);DMA_K(1,SLOTB);
  bf16x8 qr[4];
  #pragma unroll
  for(int d0=0;d0<4;++d0)qr[d0]=*reinterpret_cast<const bf16x8*>(&Qw[(long)r32*DM+d0*16+hi*8]);
  const lds_cptr qp0=shm3+LDS_Q+wid*4096+lane*16;
  #pragma unroll
  for(int d0=0;d0<4;++d0)*(__attribute__((address_space(3))) bf16x8*)(const_cast<__attribute__((address_space(3))) char*>(qp0)+d0*1024)=qr[d0];
  #define QLD(d) (*(const __attribute__((address_space(3))) bf16x8*)(qp0+(d)*1024))
  float mhat=0.f,l_reg=0.f;f32x16 o[4];o[0]=f32x16{};o[1]=f32x16{};o[2]=f32x16{};o[3]=f32x16{};
  const int qrel=wid*QBLK+r32;
  #define CMASK(P0,P1,t) do{int jb_=(t)-(NT-4); if(jb_>=0)cmask(P0,P1,jb_,qrel,hi);}while(0)
  #define ALIBI(P0,P1,t) do{ const float b0_=fmaf(sl2,(float)(64*(t)-q0e+4*hi),-mhat), b1_=fmaf(sl2,32.f,b0_); \
    _Pragma("unroll") for(int r=0;r<16;++r){P0[r]=fmaf(sl2,(float)((r&3)+8*(r>>2)),P0[r]+b0_);P1[r]=fmaf(sl2,(float)((r&3)+8*(r>>2)),P1[r]+b1_);} }while(0)
  bool resc=false;
  #define START(P0,P1) do{ const float rm=rowmax(P0,P1); resc=false; \
    { const float dl=rm; mhat=fadd_s(mhat,dl); \
      _Pragma("unroll") for(int r=0;r<16;++r){P0[r]=fsub_s(P0[r],dl);P1[r]=fsub_s(P1[r],dl);} \
      } \
    _Pragma("unroll") for(int r=0;r<16;++r)P0[r]=__builtin_amdgcn_exp2f(P0[r]); }while(0)
  #define RESC() do{ if(resc){ asm volatile("s_waitcnt lgkmcnt(0)":::"memory"); \
      _Pragma("unroll") for(int d_=0;d_<4;++d_) _Pragma("unroll") for(int r=0;r<16;++r)o[d_][r]*=wsf[crow(r,hi)]; } }while(0)
  f32x16 pA0,pA1,pB0,pB1;
  int sl_prev=0,sl_cur=0,sl_next=SLOTB;
  #define ROT() do{sl_prev=sl_cur;sl_cur=sl_next;sl_next=(sl_next==(NSLOT-1)*SLOTB)?0:sl_next+SLOTB;}while(0)
  DMA_K(2,2*SLOTB);
  WAIT_BAR(3);
  qkt(pA0,pA1,Kbase,qr,f32x16{},r32,hi);asm volatile("s_nop 15\n\ts_nop 7":"+v"(pA0),"+v"(pA1));ALIBI(pA0,pA1,0);CMASK(pA0,pA1,0);
  START(pA0,pA1);
  _Pragma("unroll") for(int r=0;r<16;++r)pA1[r]=__builtin_amdgcn_exp2f(pA1[r]);
  WAIT_BAR(0);
  DMA_K(3,0);DMA_V(1,SLOTB);
  ROT();
  kload8(kf,kp0+sl_cur);
  WAIT_BAR(3);
  s16x4 vlo[8],vhi[8]; u32x4 pw0,pw1,pw2,pw3;
  #define PKW(P,B) cvtpk_s(P[B],P[B+1])
  #define PAF(k) __builtin_bit_cast(bf16x8,pw##k)
  #define VFR(i) (bf16x8){vlo[i][0],vlo[i][1],vlo[i][2],vlo[i][3],vhi[i][0],vhi[i][1],vhi[i][2],vhi[i][3]}
  #define PIN(x) asm volatile("":"+v"(x))
  #define MX3(a,b,c) __builtin_fmaxf(__builtin_fmaxf((a),(b)),(c))
  #define GAPA(MF,A0,A1,A2,A3,W0,W1,PW) do{ MF; sacc+=A0; sacc+=A1; sacc+=A2; sacc+=A3; PIN(sacc); W0; W1; PIN(PW); SBAR(); }while(0)
  #define EX(v) __builtin_amdgcn_exp2f(v)
  #define GAPB(MF,X,B) do{ MF; X[B]=EX(X[B]); X[B+1]=EX(X[B+1]); X[B+2]=EX(X[B+2]); X[B+3]=EX(X[B+3]); PIN(X); SBAR(); }while(0)
  #define GAPB2(MF,X,B) do{ MF; X[B]=EX(X[B]); X[B+1]=EX(X[B+1]); PIN(X); SBAR(); }while(0)
  #define VRD2(i) do{ vlo[i]=vtr(vp_+((((i)+8)>>2)*4096+((i)&3)*1024)); vhi[i]=vtr(vp_+((((i)+8)>>2)*4096+((i)&3)*1024+512)); SBAR(); }while(0)
  #define VRD(i) do{ vlo[i]=vtr(vp_+(((i)>>2)*4096+((i)&3)*1024)); vhi[i]=vtr(vp_+(((i)>>2)*4096+((i)&3)*1024+512)); }while(0)
  #define KRD(G,j) do{ if(G){ kload2(kf,kp0+sl_next,j); SBAR(); } }while(0)
  #define STEP(C0,C1,P0,P1,t,GK,GV,GL) do{ SBAR(); \
    const lds_cptr vp_=vp0+2*sl_prev; \
    bf16x8 qa_=QLD(0), qb_=QLD(1); VRD(0); SBAR(); float sacc=(P0[0]+P0[1]); \
    GAPA(C0=__builtin_amdgcn_mfma_f32_32x32x16_bf16(kf[0],qa_,f32x16{},0,0,0), P0[2],P0[3],P0[4],P0[5],     pw0[0]=PKW(P0,0), pw0[1]=PKW(P0,2), pw0); \
    VRD(4); SBAR(); GAPA(C1=__builtin_amdgcn_mfma_f32_32x32x16_bf16(kf[1],qa_,f32x16{},0,0,0), P0[6],P0[7],P0[8],P0[9],     pw0[2]=PKW(P0,4), pw0[3]=PKW(P0,6), pw0); \
    qa_=QLD(2); VRD(1); SBAR(); GAPA(C0=__builtin_amdgcn_mfma_f32_32x32x16_bf16(kf[2],qb_,C0,0,0,0),   P0[10],P0[11],P0[12],P0[13], pw1[0]=PKW(P0,8), pw1[1]=PKW(P0,10), pw1); \
    VRD(5); SBAR(); GAPA(C1=__builtin_amdgcn_mfma_f32_32x32x16_bf16(kf[3],qb_,C1,0,0,0),   P0[14],P0[15],P1[0],P1[1],   pw1[2]=PKW(P0,12),pw1[3]=PKW(P0,14), pw1); \
    qb_=QLD(3); VRD(2); SBAR(); GAPA(C0=__builtin_amdgcn_mfma_f32_32x32x16_bf16(kf[4],qa_,C0,0,0,0),   P1[2],P1[3],P1[4],P1[5],     pw2[0]=PKW(P1,0), pw2[1]=PKW(P1,2), pw2); \
    VRD(6); SBAR(); GAPA(C1=__builtin_amdgcn_mfma_f32_32x32x16_bf16(kf[5],qa_,C1,0,0,0),   P1[6],P1[7],P1[8],P1[9],     pw2[2]=PKW(P1,4), pw2[3]=PKW(P1,6), pw2); \
    VRD(3); SBAR(); GAPA(C0=__builtin_amdgcn_mfma_f32_32x32x16_bf16(kf[6],qb_,C0,0,0,0),   P1[10],P1[11],P1[12],P1[13], pw3[0]=PKW(P1,8), pw3[1]=PKW(P1,10), pw3); \
    VRD(7); SBAR(); GAPA(C1=__builtin_amdgcn_mfma_f32_32x32x16_bf16(kf[7],qb_,C1,0,0,0),   P1[14],P1[15],0.f,0.f,       pw3[2]=PKW(P1,12),pw3[3]=PKW(P1,14), pw3); \
    l_reg+=sacc; \
    if(GK){DMA_K((t)+3,sl_cur);} if(GV){DMA_V((t)+1,sl_next);} \
    ALIBI(C0,C1,t); CMASK(C0,C1,t); \
    { float a=MX3(C0[0],C0[1],C1[0]),b=MX3(C0[2],C0[3],C1[1]); a=MX3(a,C1[2],C1[3]); \
      _Pragma("unroll") for(int r=4;r<16;r+=4){a=MX3(a,C0[r],C0[r+1]);b=MX3(b,C0[r+2],C0[r+3]);a=MX3(a,C1[r],C1[r+1]);b=MX3(b,C1[r+2],C1[r+3]);} \
      float rm=__builtin_fmaxf(a,b); { auto rr=__builtin_amdgcn_permlane32_swap(__float_as_uint(rm),__float_as_uint(rm),false,false); rm=__builtin_fmaxf(__uint_as_float(rr[0]),__uint_as_float(rr[1])); } \
      resc=false; \
      if(__builtin_expect(__any(rm>(float)THRL),0)){ const float dl=__builtin_fmaxf(rm,0.f); mhat+=dl; \
        _Pragma("unroll") for(int r=0;r<16;++r){C0[r]-=dl;C1[r]-=dl;} \
        const float f=__builtin_amdgcn_exp2f(-dl); l_reg*=f; if(hi==0)wsf[r32]=f; resc=true; } } \
    SBAR(); \
    GAPB2(o[0]=__builtin_amdgcn_mfma_f32_32x32x16_bf16(PAF(0),VFR(0),o[0],0,0,0), C0,0); VRD2(0); \
    GAPB2(o[1]=__builtin_amdgcn_mfma_f32_32x32x16_bf16(PAF(0),VFR(4),o[1],0,0,0), C0,2); VRD2(4); \
    KRD(GL,0); GAPB2(o[0]=__builtin_amdgcn_mfma_f32_32x32x16_bf16(PAF(1),VFR(1),o[0],0,0,0), C0,4); VRD2(1); \
    KRD(GL,1); GAPB2(o[1]=__builtin_amdgcn_mfma_f32_32x32x16_bf16(PAF(1),VFR(5),o[1],0,0,0), C0,6); VRD2(5); \
    KRD(GL,2); GAPB2(o[0]=__builtin_amdgcn_mfma_f32_32x32x16_bf16(PAF(2),VFR(2),o[0],0,0,0), C0,8); VRD2(2); \
    KRD(GL,3); GAPB2(o[1]=__builtin_amdgcn_mfma_f32_32x32x16_bf16(PAF(2),VFR(6),o[1],0,0,0), C0,10); VRD2(6); \
    GAPB2(o[0]=__builtin_amdgcn_mfma_f32_32x32x16_bf16(PAF(3),VFR(3),o[0],0,0,0), C0,12); VRD2(3); \
    GAPB2(o[1]=__builtin_amdgcn_mfma_f32_32x32x16_bf16(PAF(3),VFR(7),o[1],0,0,0), C0,14); VRD2(7); \
    GAPB2(o[2]=__builtin_amdgcn_mfma_f32_32x32x16_bf16(PAF(0),VFR(0),o[2],0,0,0), C1,0); \
    GAPB2(o[3]=__builtin_amdgcn_mfma_f32_32x32x16_bf16(PAF(0),VFR(4),o[3],0,0,0), C1,2); \
    GAPB2(o[2]=__builtin_amdgcn_mfma_f32_32x32x16_bf16(PAF(1),VFR(1),o[2],0,0,0), C1,4); \
    GAPB2(o[3]=__builtin_amdgcn_mfma_f32_32x32x16_bf16(PAF(1),VFR(5),o[3],0,0,0), C1,6); \
    GAPB2(o[2]=__builtin_amdgcn_mfma_f32_32x32x16_bf16(PAF(2),VFR(2),o[2],0,0,0), C1,8); \
    GAPB2(o[3]=__builtin_amdgcn_mfma_f32_32x32x16_bf16(PAF(2),VFR(6),o[3],0,0,0), C1,10); \
    GAPB2(o[2]=__builtin_amdgcn_mfma_f32_32x32x16_bf16(PAF(3),VFR(3),o[2],0,0,0), C1,12); \
    GAPB2(o[3]=__builtin_amdgcn_mfma_f32_32x32x16_bf16(PAF(3),VFR(7),o[3],0,0,0), C1,14); \
    }while(0)
  int t=1;
  #undef CMASK
  #define CMASK(P0,P1,t) do{}while(0)
  for(;t+5<NT;t+=2){
    STEP(pB0,pB1,pA0,pA1,t,true,true,true);     WAIT_BAR(3); RESC(); ROT();
    STEP(pA0,pA1,pB0,pB1,t+1,true,true,true);   WAIT_BAR(3); RESC(); ROT();
  }
  #undef CMASK
  #define CMASK(P0,P1,t) do{int jb_=(t)-(NT-4); if(jb_>=0)cmask(P0,P1,jb_,qrel,hi);}while(0)
  #define ENDW(tt) do{ if((tt)+3<NT){WAIT_BAR(3);} else if((tt)+2<NT){WAIT_BAR(2);} else {WAIT_BAR(0);} }while(0)
  for(;t+1<NT;t+=2){
    STEP(pB0,pB1,pA0,pA1,t,(t+3<NT),(t+1<NT),(t+1<NT));       ENDW(t);   RESC(); ROT();
    STEP(pA0,pA1,pB0,pB1,t+1,(t+4<NT),(t+2<NT),(t+2<NT));     ENDW(t+1); RESC(); ROT();
  }
  STEP(pB0,pB1,pA0,pA1,NT-1,false,false,false); RESC();
  { float sacc=pB0[0]+pB0[1]; _Pragma("unroll") for(int r=2;r<16;++r)sacc+=pB0[r]; _Pragma("unroll") for(int r=0;r<16;++r)sacc+=pB1[r]; l_reg+=sacc;
    pw0=(u32x4){PKW(pB0,0),PKW(pB0,2),PKW(pB0,4),PKW(pB0,6)};pw1=(u32x4){PKW(pB0,8),PKW(pB0,10),PKW(pB0,12),PKW(pB0,14)};pw2=(u32x4){PKW(pB1,0),PKW(pB1,2),PKW(pB1,4),PKW(pB1,6)};pw3=(u32x4){PKW(pB1,8),PKW(pB1,10),PKW(pB1,12),PKW(pB1,14)};
    SBAR(); pv(o,vb0+2*sl_cur,PAF(0),PAF(1),PAF(2),PAF(3)); }
  #undef PKW
  #undef PAF
  #undef VFR
  #undef PIN
  #undef MX3
  #undef GAPA
  #undef GAPB
  #undef GAPB2
  #undef VRD2
  #undef EX
  #undef VRD
  #undef KRD
  #undef STEP
  #undef ENDW
  {auto rr=__builtin_amdgcn_permlane32_swap(__float_as_uint(l_reg),__float_as_uint(l_reg),false,false);l_reg=__uint_as_float(rr[0])+__uint_as_float(rr[1]);}
  if(hi==0)wsf[32+r32]=l_reg;asm volatile("s_waitcnt lgkmcnt(0)":::"memory");
  float rli[16];
  #pragma unroll
  for(int r=0;r<16;++r)rli[r]=__builtin_amdgcn_rcpf(wsf[32+crow(r,hi)]);
  bf16*Ow=Ob+(long)(wid*QBLK)*opitch;
  { bf16*stg=(bf16*)(shm+LDS_OST)+wid*2048;
    #pragma unroll
    for(int hf=0;hf<2;++hf){
      #pragma unroll
      for(int r=0;r<16;++r){const int orow=crow(r,hi);
        #pragma unroll
        for(int d0=0;d0<2;++d0)stg[orow*64+d0*32+r32]=__float2bfloat16(o[2*hf+d0][r]*rli[r]);}
      asm volatile("s_waitcnt lgkmcnt(0)":::"memory");
      #pragma unroll
      for(int i=0;i<4;++i){const int row=i*8+(lane>>3),ch=lane&7; const u32x4 v=*(const u32x4*)(stg+row*64+ch*8); ATTN_STORE16(Ow+(long)row*opitch+hf*64+ch*8,v);}
      asm volatile("s_waitcnt lgkmcnt(0)":::"memory"); } }
  asm volatile("s_waitcnt lgkmcnt(0)\n\ts_barrier":::"memory");
  #undef DMA_K
  #undef DMA_V
  #undef QLD
  #undef CMASK
  #undef ALIBI
  #undef START
  #undef RESC
  #undef ROT
}
constexpr int ATTN_LDS_BYTES=LDS_BYTES;
#undef SBAR
#undef WAIT_BAR
}
constexpr int NWAVES = 8, NTHR = 512;
constexpr int BATCH = 4, SEQ = 4096, TT = BATCH * SEQ, DMOD = 1024, FF = 4096, DIN = 8200;
constexpr float EPSN = 1e-6f;
constexpr size_t MiB = 1u << 20;
constexpr size_t WS_WIN = 0, WS_W1T = 0, WS_W2T = 8 * MiB;
constexpr size_t WS_XN = 16 * MiB;
constexpr size_t WS_B0 = 48 * MiB, WS_BSTR = 32 * MiB;
constexpr size_t WS_H = 48 * MiB;
constexpr size_t WS_WAT = 240 * MiB, WS_WMT = 242 * MiB, WS_WOT = 244 * MiB, WS_IF = 246 * MiB, WS_CTL = 247 * MiB, WS_END = 248 * MiB;
constexpr size_t CTL_BYTES = 256 * 1024;
constexpr int RING_BYTES = 131072, LDS_BYTES = 147456, MISC_OFF = LDS_BYTES - 256;

#define LAS __attribute__((address_space(3)))
typedef unsigned short bf16;
typedef unsigned v4u __attribute__((ext_vector_type(4)));
typedef unsigned v2u __attribute__((ext_vector_type(2)));
typedef float f32x4 __attribute__((ext_vector_type(4)));
typedef float f32x16 __attribute__((ext_vector_type(16)));
typedef short bf16x8 __attribute__((ext_vector_type(8)));
typedef short s16x4 __attribute__((ext_vector_type(4)));
__device__ __forceinline__ unsigned f2bf(float f) { unsigned u = __builtin_bit_cast(unsigned, f); return (u + 0x7fffu + ((u >> 16) & 1u)) >> 16; }
__device__ __forceinline__ unsigned pk2(float lo, float hi) { return f2bf(lo) | (f2bf(hi) << 16); }
__device__ __forceinline__ unsigned cvtpk(float lo, float hi) { return pg8::cvt_pk_bf16(lo, hi); }
__device__ __forceinline__ float bflo(unsigned w) { return __uint_as_float(w << 16); }
__device__ __forceinline__ float bfhi(unsigned w) { return __uint_as_float(w & 0xffff0000u); }
__device__ __forceinline__ float wave_sum(float v) {
#pragma unroll
    for (int o = 1; o < 64; o <<= 1) v += sx(v, o);
    return v;
}
__device__ __forceinline__ void transpose_item(const float* W, int ldw, int K, bf16* WT, int nd0, int ns0, int k0, const float* kscale, LAS float* scr, int lane) {
    float tv[32];
#pragma unroll
    for (int i = 0; i < 32; ++i) { const int kk = 2 * i + (lane >> 5); tv[i] = __builtin_nontemporal_load(W + (size_t)(k0 + kk) * ldw + ns0 + (lane & 31)); }
#pragma unroll
    for (int i = 0; i < 32; ++i) { const int kk = 2 * i + (lane >> 5); float v = tv[i]; if (kscale) v *= kscale[k0 + kk]; scr[kk * 33 + (lane & 31)] = v; }
    asm volatile("s_waitcnt lgkmcnt(0)" ::: "memory");
    const int c = lane & 7;
#pragma unroll
    for (int j = 0; j < 4; ++j) { const int n = (lane >> 3) + 8 * j; const LAS float* s = scr + (8 * c) * 33 + n;
        v4u o; o.x = pk2(s[0 * 33], s[1 * 33]); o.y = pk2(s[2 * 33], s[3 * 33]); o.z = pk2(s[4 * 33], s[5 * 33]); o.w = pk2(s[6 * 33], s[7 * 33]);
        *(v4u*)(WT + (size_t)(nd0 + n) * K + k0 + 8 * c) = o; }
    asm volatile("s_waitcnt lgkmcnt(0)" ::: "memory");
}

namespace mls {
constexpr int OFF_QS = 0, OFF_KS = 17408, OFF_KTS = 34816, OFF_VTS = 53248, OFF_PS = 90112, OFF_CS = 99328, OFF_RS = 99584, OFF_QN = 100096, OFF_NV = 100352, OFF_HSQ = 100864, OFF_NG = 102912;
constexpr int QPB = 272, SPB = 144;
#define MFMA32(a, b, c) __builtin_amdgcn_mfma_f32_32x32x16_bf16((a), (b), (c), 0, 0, 0)
__device__ __forceinline__ bf16x8 ld128(LAS const unsigned char* p) { return *(LAS const bf16x8*)p; }
__device__ __forceinline__ float bfe(const v4u& u, int i) { const unsigned w = (i >> 1) == 0 ? u.x : (i >> 1) == 1 ? u.y : (i >> 1) == 2 ? u.z : u.w; return (i & 1) ? bfhi(w) : bflo(w); }

__device__ __forceinline__ float shf(float v, int src) { return __builtin_bit_cast(float, __builtin_amdgcn_ds_bpermute(src << 2, __builtin_bit_cast(int, v))); }
constexpr int OFF_MC = 103936, OFF_M63 = 104192, OFF_G = 104448, OFF_CM = 104704;
#define CH_FRESH() int tid = tid0; asm volatile("" : "+v"(tid)); const int lane = tid & 63, r32 = lane & 31, hi = lane >> 5; (void)r32; (void)hi
constexpr int NSEG = 8, CPS = 64 / NSEG;
constexpr size_t ST_FLOATS = 128 * 256 + 128 + 64;
static_assert(MiB + 16 * (NSEG - 1) * ST_FLOATS * 4 <= 16 * MiB, "chain state scratch must fit the upper half of B3");
template <bool FULL>
__device__ __forceinline__ void chain_run(LAS unsigned char* L, const int tid0, const int wid, const int h, const size_t row0, const int c0, const bf16* QKc, bf16* MV, const bf16* MLO, const f32x4* GS, f32x16 (&acc)[4]) {
    LAS float* CS = (LAS float*)(L + OFF_CS); LAS float* RS = (LAS float*)(L + OFF_RS); LAS float* QN = (LAS float*)(L + OFF_QN);
    LAS float* NV = (LAS float*)(L + OFF_NV); LAS float* HSQ = (LAS float*)(L + OFF_HSQ); LAS float* NG = (LAS float*)(L + OFF_NG);
    LAS float* MC = (LAS float*)(L + OFF_MC); LAS float* M63A = (LAS float*)(L + OFF_M63);
    const bool isK = wid < 4;
    v4u pq[4], pv[4]; f32x4 gsv;
#define CH_PREFETCH(ci) do { CH_FRESH(); int c_ = (ci); asm volatile("" : "+s"(c_)); const size_t rb_ = row0 + (size_t)(c0 + c_) * 64; \
        const char* qb_ = (const char*)QKc + rb_ * 2048; const char* vb_ = (const char*)MV + rb_ * 2048; \
        if (isK) { const unsigned koff = (unsigned)(((4 * ((tid >> 4) & 15)) * 1024 + 512 + h * 128 + 8 * (tid & 15)) * 2); \
            _Pragma("unroll") for (int j = 0; j < 4; ++j) pq[j] = *(const v4u*)(qb_ + koff + j * 2048); } \
        else if (FULL) { const unsigned koff = (unsigned)(((((tid - 256) >> 2)) * 1024 + h * 128 + 32 * ((tid - 256) & 3)) * 2); \
            _Pragma("unroll") for (int j = 0; j < 4; ++j) pq[j] = *(const v4u*)(qb_ + koff + j * 16); } \
        { const unsigned voff = (unsigned)(((4 * (tid >> 5)) * 1024 + h * 256 + 8 * (tid & 31)) * 2); \
            _Pragma("unroll") for (int j = 0; j < 4; ++j) pv[j] = *(const v4u*)(vb_ + voff + j * 2048); } \
        gsv = GS[c_ * 64 + lane]; } while (0)
    CH_PREFETCH(0);
#pragma unroll 1
    for (int c = 0; c < CPS; ++c) {
        int cq = c; asm volatile("" : "+s"(cq)); const size_t rb = row0 + (size_t)(c0 + cq) * 64;
        float Mt, wint, flr, decay;
        {
            CH_FRESH();
            const float mc = MC[cq], m63 = M63A[cq];
            const float bb = gsv[0], cc = gsv[1], cm = gsv[2];
            Mt = fmaxf(mc, cm);
            wint = __expf(mc - Mt);
            flr = __expf(-(bb + Mt));
            const float wsc = __expf(cc - m63);
            decay = __expf(mc - m63);
            if (FULL && wid == 0) CS[lane] = cc;
            if (isK) {
                const int kcg = tid & 15, ktg = (tid >> 4) & 15;
                float w4[4];
#pragma unroll
                for (int j = 0; j < 4; ++j) { w4[j] = shf(wsc, 4 * ktg + j); if (FULL) *(LAS v4u*)(L + OFF_KS + (4 * ktg + j) * QPB + kcg * 16) = pq[j]; }
#pragma unroll
                for (int i = 0; i < 8; ++i) { v2u o; o.x = cvtpk(bfe(pq[0], i) * w4[0], bfe(pq[1], i) * w4[1]); o.y = cvtpk(bfe(pq[2], i) * w4[2], bfe(pq[3], i) * w4[3]);
                    *(LAS v2u*)(L + OFF_KTS + (8 * kcg + i) * SPB + ktg * 8) = o; }
            } else if (FULL) {
                const int qt = (tid - 256) >> 2, qdg = (tid - 256) & 3;
#pragma unroll
                for (int j = 0; j < 4; ++j) *(LAS v4u*)(L + OFF_QS + qt * QPB + (32 * qdg + 8 * j) * 2) = pq[j];
            }
            const int vdg = tid & 31, vsg = tid >> 5;
#pragma unroll
            for (int i = 0; i < 8; ++i) { v2u o;
                const unsigned a0 = (i >> 1) == 0 ? pv[0].x : (i >> 1) == 1 ? pv[0].y : (i >> 1) == 2 ? pv[0].z : pv[0].w;
                const unsigned a1 = (i >> 1) == 0 ? pv[1].x : (i >> 1) == 1 ? pv[1].y : (i >> 1) == 2 ? pv[1].z : pv[1].w;
                const unsigned a2 = (i >> 1) == 0 ? pv[2].x : (i >> 1) == 1 ? pv[2].y : (i >> 1) == 2 ? pv[2].z : pv[2].w;
                const unsigned a3 = (i >> 1) == 0 ? pv[3].x : (i >> 1) == 1 ? pv[3].y : (i >> 1) == 2 ? pv[3].z : pv[3].w;
                if (i & 1) { o.x = (a0 >> 16) | (a1 & 0xffff0000u); o.y = (a2 >> 16) | (a3 & 0xffff0000u); }
                else       { o.x = (a0 & 0xffffu) | (a1 << 16);     o.y = (a2 & 0xffffu) | (a3 << 16); }
                *(LAS v2u*)(L + OFF_VTS + (8 * vdg + i) * SPB + vsg * 8) = o; }
        }
        __syncthreads();
        if (c + 1 < CPS) CH_PREFETCH(c + 1);
        v2u op[2][4];
        f32x16 nT[2];
        if (FULL) {
            {   CH_FRESH();
                const unsigned ooff = (unsigned)((r32 * 1024 + h * 256 + 32 * wid + 4 * hi) * 2);
#pragma unroll
                for (int tt = 0; tt < 2; ++tt)
#pragma unroll
                    for (int j = 0; j < 4; ++j) op[tt][j] = *(const v2u*)((const char*)MLO + (rb * 2048 + tt * 65536) + ooff + j * 16);
            }
            nT[0] = f32x16{}; nT[1] = f32x16{};
            {
                CH_FRESH();
                if (wid < 4) {
                    const int st = wid & 1, tt = wid >> 1, t = 32 * tt + r32;
                    if (st == 1 && tt == 0) {
#pragma unroll
                        for (int j = 0; j < 4; ++j) *(LAS v2u*)(L + OFF_PS + t * SPB + (32 + 8 * j + 4 * hi) * 2) = (v2u){0u, 0u};
                        if (hi == 0) RS[64 + t] = 0.f;
                    } else {
                        f32x16 sT = f32x16{};
                        LAS const unsigned char* kp = L + OFF_KS + (32 * st + r32) * QPB + 16 * hi; LAS const unsigned char* qp = L + OFF_QS + t * QPB + 16 * hi;
#pragma unroll
                        for (int half = 0; half < 2; ++half) { bf16x8 ka[4], qa[4];
#pragma unroll
                            for (int kk = 0; kk < 4; ++kk) { ka[kk] = ld128(kp + (4 * half + kk) * 32); qa[kk] = ld128(qp + (4 * half + kk) * 32); }
#pragma unroll
                            for (int kk = 0; kk < 4; ++kk) sT = MFMA32(ka[kk], qa[kk], sT); }
                        const float Mtl = shf(Mt, t);
                        float sum = 0.f;
#pragma unroll
                        for (int j = 0; j < 4; ++j) { const int s0 = 32 * st + 8 * j + 4 * hi; const f32x4 c4 = *(LAS const f32x4*)(CS + s0); float v[4];
#pragma unroll
                            for (int i = 0; i < 4; ++i) { const float e = __expf(fminf(c4[i] - Mtl, 0.f)); v[i] = (s0 + i <= t) ? sT[4 * j + i] * e : 0.f; sum += v[i]; }
                            v2u o; o.x = cvtpk(v[0], v[1]); o.y = cvtpk(v[2], v[3]); *(LAS v2u*)(L + OFF_PS + t * SPB + s0 * 2) = o; }
                        sum += shf(sum, lane ^ 32);
                        if (hi == 0) RS[64 * st + t] = sum;
                    }
                }
#pragma unroll
                for (int Td = 0; Td < 4; ++Td) {
                    v2u qv[2][2][2];
#pragma unroll
                    for (int jj = 0; jj < 2; ++jj)
#pragma unroll
                        for (int tt = 0; tt < 2; ++tt) { LAS const unsigned char* qp = L + OFF_QS + (32 * tt + r32) * QPB + (32 * Td + 16 * jj + 4 * hi) * 2;
                            qv[jj][tt][0] = *(LAS const v2u*)qp; qv[jj][tt][1] = *(LAS const v2u*)(qp + 16); }
#pragma unroll
                    for (int jj = 0; jj < 2; ++jj) {
                        v4u aw; aw.x = cvtpk(acc[Td][8 * jj + 0], acc[Td][8 * jj + 1]); aw.y = cvtpk(acc[Td][8 * jj + 2], acc[Td][8 * jj + 3]); aw.z = cvtpk(acc[Td][8 * jj + 4], acc[Td][8 * jj + 5]); aw.w = cvtpk(acc[Td][8 * jj + 6], acc[Td][8 * jj + 7]);
                        const bf16x8 af = __builtin_bit_cast(bf16x8, aw);
#pragma unroll
                        for (int tt = 0; tt < 2; ++tt) { const v4u qw = {qv[jj][tt][0].x, qv[jj][tt][0].y, qv[jj][tt][1].x, qv[jj][tt][1].y};
                            nT[tt] = MFMA32(af, __builtin_bit_cast(bf16x8, qw), nT[tt]); }
                    }
                }
                { const int t = 8 * wid + (lane >> 3), dp = lane & 7; LAS const unsigned char* qp = L + OFF_QS + t * QPB + dp * 32;
                    const v4u qa = *(LAS const v4u*)qp, qb = *(LAS const v4u*)(qp + 16); float d = 0.f;
#pragma unroll
                    for (int i = 0; i < 4; ++i) { const f32x4 n4 = *(LAS const f32x4*)(NV + 16 * dp + 4 * i); const v4u& q = (i < 2) ? qa : qb; const unsigned w0 = (i & 1) ? q.z : q.x, w1 = (i & 1) ? q.w : q.y;
                        d += bflo(w0) * n4[0] + bfhi(w0) * n4[1] + bflo(w1) * n4[2] + bfhi(w1) * n4[3]; }
                    d += shf(d, lane ^ 1); d += shf(d, lane ^ 2); d += shf(d, lane ^ 4);
                    if (dp == 0) QN[t] = d; }
            }
            __syncthreads();
        }
        {
            CH_FRESH();
            bf16x8 vf[4], pb[2][4], ka[4];
#pragma unroll
            for (int kk = 0; kk < 4; ++kk) vf[kk] = ld128(L + OFF_VTS + (32 * wid + r32) * SPB + (16 * kk + 8 * hi) * 2);
            if (FULL) {
#pragma unroll
                for (int tt = 0; tt < 2; ++tt)
#pragma unroll
                    for (int kk = 0; kk < 4; ++kk) if (tt == 1 || kk < 2) pb[tt][kk] = ld128(L + OFF_PS + (32 * tt + r32) * SPB + (16 * kk + 8 * hi) * 2);
            }
#pragma unroll
            for (int kk = 0; kk < 4; ++kk) ka[kk] = ld128(L + OFF_KTS + r32 * SPB + (16 * kk + 8 * hi) * 2);
            float dn[2];
            if (FULL) {
#pragma unroll
                for (int tt = 0; tt < 2; ++tt) { const int t = 32 * tt + r32; const float wl = shf(wint, t), fl = shf(flr, t);
                    const float den = wl * QN[t] + RS[t] + RS[64 + t]; dn[tt] = 1.f / fmaxf(fabsf(den), fl);
#pragma unroll
                    for (int r = 0; r < 16; ++r) nT[tt][r] *= wl; }
#pragma unroll
                for (int tt = 0; tt < 2; ++tt)
#pragma unroll
                    for (int kk = 0; kk < 4; ++kk) if (tt == 1 || kk < 2) nT[tt] = MFMA32(vf[kk], pb[tt][kk], nT[tt]);
            }
#pragma unroll
            for (int Td = 0; Td < 4; ++Td) {
#pragma unroll
                for (int r = 0; r < 16; ++r) acc[Td][r] *= decay;
#pragma unroll
                for (int kk = 0; kk < 4; ++kk) acc[Td] = MFMA32(ka[kk], vf[kk], acc[Td]);
                if (Td < 3) {
#pragma unroll
                    for (int kk = 0; kk < 4; ++kk) ka[kk] = ld128(L + OFF_KTS + (32 * (Td + 1) + r32) * SPB + (16 * kk + 8 * hi) * 2);
                }
            }
            if (FULL) {
#pragma unroll
                for (int tt = 0; tt < 2; ++tt) { const int t = 32 * tt + r32; float hs = 0.f;
#pragma unroll
                    for (int r = 0; r < 16; ++r) { nT[tt][r] *= dn[tt]; hs += nT[tt][r] * nT[tt][r]; }
                    hs += shf(hs, lane ^ 32);
                    if (hi == 0) HSQ[wid * 64 + t] = hs; }
            }
            if (tid < 128) { float s = 0.f;
#pragma unroll
                for (int i = 0; i < 8; ++i) { const v4u k8 = *(LAS const v4u*)(L + OFF_KTS + tid * SPB + i * 16); s += (bflo(k8.x) + bfhi(k8.x)) + (bflo(k8.y) + bfhi(k8.y)) + (bflo(k8.z) + bfhi(k8.z)) + (bflo(k8.w) + bfhi(k8.w)); }
                NV[tid] = decay * NV[tid] + s; }
        }
        __syncthreads();
        if (FULL) {
            CH_FRESH();
            const unsigned ooff = (unsigned)((r32 * 1024 + h * 256 + 32 * wid + 4 * hi) * 2);
#pragma unroll
            for (int tt = 0; tt < 2; ++tt) { const int t = 32 * tt + r32; float hsum = 0.f;
#pragma unroll
                for (int w = 0; w < 8; ++w) hsum += HSQ[w * 64 + t];
                const float rstd = __builtin_amdgcn_rsqf(hsum * (1.f / 256.f) + EPSN);
#pragma unroll
                for (int j = 0; j < 4; ++j) { const v2u ow = op[tt][j];
                    const float y0 = nT[tt][4 * j + 0] * rstd * bflo(ow.x), y1 = nT[tt][4 * j + 1] * rstd * bfhi(ow.x);
                    const float y2 = nT[tt][4 * j + 2] * rstd * bflo(ow.y), y3 = nT[tt][4 * j + 3] * rstd * bfhi(ow.y);
                    v2u o; o.x = cvtpk(y0, y1); o.y = cvtpk(y2, y3);
                    *(v2u*)((char*)MV + (rb * 2048 + tt * 65536) + ooff + j * 16) = o; } }
        }
    }
    __syncthreads();
#undef CH_PREFETCH
}

__device__ __forceinline__ void chain(LAS unsigned char* L, int b, int h, int seg, const bf16* QKc, bf16* MV, const bf16* MLO, const float* IFg, const float* ng, f32x4* GSall, float* STbh, unsigned* flags, const int wid) {
    const int tid0 = fresh_tid(wid);
    const size_t row0 = (size_t)b * SEQ; const int c0 = seg * CPS;
    LAS float* NV = (LAS float*)(L + OFF_NV); LAS float* NG = (LAS float*)(L + OFF_NG);
    LAS float* MC = (LAS float*)(L + OFF_MC); LAS float* M63A = (LAS float*)(L + OFF_M63); LAS float* GG = (LAS float*)(L + OFF_G); LAS float* CM63 = (LAS float*)(L + OFF_CM);
    f32x4* GS = GSall + (size_t)c0 * 64;
    if (tid0 < 128) NV[tid0] = 0.f;
    if (tid0 < 256) NG[tid0] = ng[h * 256 + tid0];
    {
        CH_FRESH();
        const int c = wid;
        const size_t tok = row0 + (size_t)(c0 + c) * 64 + lane;
        const float gi = IFg[tok * 8 + h], gf = IFg[tok * 8 + 4 + h];
        const float lf = fminf(gf, 0.f) - log1pf(__expf(-fabsf(gf)));
        float bb = lf;
#pragma unroll
        for (int o = 1; o < 64; o <<= 1) { const float v = shf(bb, lane - o); if (lane >= o) bb += v; }
        const float cc = gi - bb;
        float cm = cc;
#pragma unroll
        for (int o = 1; o < 64; o <<= 1) { const float v = shf(cm, lane - o); if (lane >= o) cm = fmaxf(cm, v); }
        GS[c * 64 + lane] = (f32x4){bb, cc, cm, 0.f};
        if (lane == 63) { GG[c] = bb; CM63[c] = cm; }
        asm volatile("s_waitcnt vmcnt(0)" ::: "memory");
        __syncthreads();
    }
    f32x16 acc[4];
#pragma unroll
    for (int i = 0; i < 4; ++i) acc[i] = f32x16{};
    float* STme = STbh + (size_t)seg * ST_FLOATS;
    if (seg < NSEG - 1) {
        { CH_FRESH(); if (tid == 0) { float m = 0.f, gs = 0.f;
            for (int c = 0; c < CPS; ++c) { MC[c] = m; const float m63 = fmaxf(m, CM63[c]); M63A[c] = m63; m = GG[c] + m63; gs += GG[c]; }
            STme[128 * 256 + 128] = m; STme[128 * 256 + 129] = gs; } }
        __syncthreads();
        chain_run<false>(L, tid0, wid, h, row0, c0, QKc, MV, MLO, GS, acc);
        { CH_FRESH();
#pragma unroll
            for (int Td = 0; Td < 4; ++Td)
#pragma unroll
                for (int r = 0; r < 16; ++r) STme[((wid * 4 + Td) * 16 + r) * 64 + lane] = acc[Td][r];
            if (tid < 128) STme[128 * 256 + tid] = NV[tid];
            asm volatile("s_waitcnt vmcnt(0)" ::: "memory");
            __syncthreads();
            if (tid == 0) { __builtin_amdgcn_fence(__ATOMIC_RELEASE, "agent"); asm volatile("s_waitcnt vmcnt(0)" ::: "memory"); __hip_atomic_store(flags + 16 * seg, 1u, __ATOMIC_RELAXED, __HIP_MEMORY_SCOPE_AGENT); }
        }
    }
    float m0 = 0.f;
    {   CH_FRESH();
        if (seg > 0) {
            if (tid == 0) {
                for (int j = 0; j < seg; ++j) { unsigned sp = 0; while (__hip_atomic_load(flags + 16 * j, __ATOMIC_RELAXED, __HIP_MEMORY_SCOPE_AGENT) == 0u && ++sp < (1u << 22)) __builtin_amdgcn_s_sleep(2); }
                __builtin_amdgcn_fence(__ATOMIC_ACQUIRE, "agent"); asm volatile("s_waitcnt vmcnt(0)" ::: "memory");
            }
            __syncthreads();
        }
#pragma unroll
        for (int i = 0; i < 4; ++i) acc[i] = f32x16{};
        float nreg = 0.f;
#pragma unroll 1
        for (int j = 0; j < seg; ++j) { const float* Sj = STbh + (size_t)j * ST_FLOATS;
            const float ml = __builtin_nontemporal_load(Sj + 128 * 256 + 128), gsum = __builtin_nontemporal_load(Sj + 128 * 256 + 129);
            const float mn = fmaxf(gsum + m0, ml); const float fa = __expf(gsum + m0 - mn), fb = __expf(ml - mn);
#pragma unroll
            for (int Td = 0; Td < 4; ++Td)
#pragma unroll
                for (int r = 0; r < 16; ++r) acc[Td][r] = fa * acc[Td][r] + fb * Sj[((wid * 4 + Td) * 16 + r) * 64 + lane];
            if (tid < 128) nreg = fa * nreg + fb * Sj[128 * 256 + tid];
            m0 = mn; }
        __syncthreads();
        if (tid < 128) NV[tid] = nreg;
        if (tid == 0) { float m = m0;
            for (int c = 0; c < CPS; ++c) { MC[c] = m; const float m63 = fmaxf(m, CM63[c]); M63A[c] = m63; m = GG[c] + m63; } }
        __syncthreads();
    }
    chain_run<true>(L, tid0, wid, h, row0, c0, QKc, MV, MLO, GS, acc);
#undef CH_FRESH
}
}
#define RLX_AGENT __ATOMIC_RELAXED, __HIP_MEMORY_SCOPE_AGENT
#define LDS_WAIT() asm volatile("s_waitcnt lgkmcnt(0)" ::: "memory")
#define VM_WAIT() asm volatile("s_waitcnt vmcnt(0)" ::: "memory")
#define XB_TMO      128
#define XB_XCNT(j)  (256  + 64 * (j))
#define XB_XSUB(j)  (1280 + 64 * (j))
#define XB_XGEN(j)  (2304 + 64 * (j))
#define XB_TOP      3328
#define XB_TOPGEN   3392
#define XCD_BAR_WORDS 3456
#define XB_SPIN_CAP (1u << 18)

__device__ __forceinline__ unsigned xb_ld(unsigned* p)              { return __hip_atomic_load(p, __ATOMIC_RELAXED, __HIP_MEMORY_SCOPE_AGENT); }
__device__ __forceinline__ unsigned xb_add(unsigned* p, unsigned v) { return __hip_atomic_fetch_add(p, v, __ATOMIC_RELAXED, __HIP_MEMORY_SCOPE_AGENT); }
__device__ __forceinline__ unsigned xb_xcc_id() { return (unsigned)__builtin_amdgcn_s_getreg((3 << 11) | 20) & 0xFu; }
#define XB_SPIN(cond, bar) do { unsigned _sp = 0; while (cond) { __builtin_amdgcn_s_sleep(1); \
    if ((++_sp & 255u) == 0u) { if (xb_ld(&(bar)[XB_TMO])) break; if (_sp > XB_SPIN_CAP) { atomicAdd(&(bar)[XB_TMO], 1u); break; } } } } while (0)

struct XcdBarrier {
    unsigned* bar; unsigned x;
    volatile LAS unsigned* st;
};

__device__ __forceinline__ XcdBarrier xcd_barrier_post(unsigned* bar, volatile LAS unsigned* st) {
    XcdBarrier b; b.bar = bar; b.x = xb_xcc_id(); b.st = st;
    if (threadIdx.x == 0) (void)xb_add(&bar[XB_XCNT(b.x)], 1u);
    return b;
}
__device__ __forceinline__ void xcd_barrier_complete(unsigned* bar, unsigned x, unsigned& nloc, unsigned& nx) {
    const unsigned G = gridDim.x * gridDim.y * gridDim.z;
    unsigned sum, cnt, mine, sp = 0u;
    for (;;) {
        sum = 0u; cnt = 0u; mine = 0u;
#pragma unroll
        for (unsigned j = 0; j < 16; ++j) { const unsigned c = xb_ld(&bar[XB_XCNT(j)]); sum += c; cnt += (c > 0u) ? 1u : 0u; mine = (j == x) ? c : mine; }
        if (sum == G) break;
        __builtin_amdgcn_s_sleep(1);
        if ((++sp & 255u) == 0u) { if (xb_ld(&bar[XB_TMO])) break; if (sp > XB_SPIN_CAP) { atomicAdd(&bar[XB_TMO], 1u); break; } }
    }
    nloc = mine > 0u ? mine : 1u; nx = cnt > 0u ? cnt : 1u;
}

__device__ __forceinline__ void xcd_barrier(const XcdBarrier& b) {
    asm volatile("s_waitcnt vmcnt(0)" ::: "memory");
    __syncthreads();
    if (threadIdx.x == 0) {
        unsigned* bar = b.bar;
        __builtin_amdgcn_s_waitcnt(0);
        unsigned nloc = b.st[0], nx = b.st[1];
        if (nloc == 0u) { xcd_barrier_complete(bar, b.x, nloc, nx); b.st[0] = nloc; b.st[1] = nx; }
        const unsigned old = xb_add(&bar[XB_XSUB(b.x)], 1u);
        const unsigned gen = old / nloc;
        if (old + 1u == (gen + 1u) * nloc) {
            __builtin_amdgcn_fence(__ATOMIC_RELEASE, "agent");
            asm volatile("s_waitcnt vmcnt(0)" ::: "memory");
            const unsigned og = xb_add(&bar[XB_TOP], 1u);
            const unsigned tg = og / nx;
            if (og + 1u == (tg + 1u) * nx) xb_add(&bar[XB_TOPGEN], 1u);
            else XB_SPIN(xb_ld(&bar[XB_TOPGEN]) == tg, bar);
            __builtin_amdgcn_fence(__ATOMIC_ACQUIRE, "agent");
            xb_add(&bar[XB_XGEN(b.x)], 1u);
            asm volatile("s_waitcnt vmcnt(0)" ::: "memory");
        } else {
            XB_SPIN(xb_ld(&bar[XB_XGEN(b.x)]) == gen, bar);
            __builtin_amdgcn_fence(__ATOMIC_ACQUIRE, "agent");
            asm volatile("s_waitcnt vmcnt(0)" ::: "memory");
        }
    }
    __syncthreads();
}

__device__ const unsigned short ATT_ORDER[512] = {484,492,500,508,485,493,501,509,486,494,502,510,487,495,503,511,452,460,468,476,453,461,469,477,454,462,470,478,455,463,471,479,420,428,436,444,421,429,437,445,422,430,438,446,423,431,439,447,388,396,404,412,389,397,405,413,390,398,406,414,391,399,407,415,356,364,372,380,357,365,373,381,358,366,374,382,359,367,375,383,324,332,340,348,325,333,341,349,326,334,342,350,327,335,343,351,292,300,308,316,293,301,309,317,294,302,310,318,295,303,311,319,483,491,499,507,451,459,467,475,419,427,435,443,387,395,403,411,355,363,371,379,323,331,339,347,291,299,307,315,259,267,275,283,260,268,276,284,261,269,277,285,262,270,278,286,263,271,279,287,227,235,243,251,228,236,244,252,229,237,245,253,230,238,246,254,231,239,247,255,195,203,211,219,196,204,212,220,197,205,213,221,198,206,214,222,199,207,215,223,163,171,179,187,164,172,180,188,165,173,181,189,166,174,182,190,167,175,183,191,482,490,498,506,450,458,466,474,418,426,434,442,386,394,402,410,354,362,370,378,322,330,338,346,290,298,306,314,258,266,274,282,226,234,242,250,194,202,210,218,162,170,178,186,130,138,146,154,131,139,147,155,132,140,148,156,133,141,149,157,134,142,150,158,135,143,151,159,98,106,114,122,99,107,115,123,100,108,116,124,101,109,117,125,102,110,118,126,103,111,119,127,481,489,497,505,449,457,465,473,417,425,433,441,385,393,401,409,353,361,369,377,321,329,337,345,289,297,305,313,257,265,273,281,225,233,241,249,193,201,209,217,161,169,177,185,129,137,145,153,97,105,113,121,65,73,81,89,66,74,82,90,67,75,83,91,68,76,84,92,69,77,85,93,70,78,86,94,71,79,87,95,480,488,496,504,448,456,464,472,416,424,432,440,384,392,400,408,352,360,368,376,320,328,336,344,288,296,304,312,256,264,272,280,224,232,240,248,192,200,208,216,160,168,176,184,128,136,144,152,96,104,112,120,64,72,80,88,32,40,48,56,33,41,49,57,34,42,50,58,35,43,51,59,36,44,52,60,37,45,53,61,38,46,54,62,39,47,55,63,0,8,16,24,1,9,17,25,2,10,18,26,3,11,19,27,4,12,20,28,5,13,21,29,6,14,22,30,7,15,23,31};
struct Args { const float* in[17]; float* out; unsigned char* ws; };
enum { I_X = 0, I_NMIX, I_WIN, I_BGATES, I_CONVW, I_CONVB, I_LAM, I_DANG, I_MLNG, I_BMERGE, I_WA, I_WM, I_WOUT, I_NMLP, I_WFF1, I_WFF2, I_NFIN };

__global__ void __launch_bounds__(NTHR, 2) mk_fwd(Args a) {
    extern __shared__ __attribute__((aligned(16))) unsigned char lds[];
    cg::grid_group grid = cg::this_grid();
    LAS unsigned char* L = (LAS unsigned char*)lds;
    volatile LAS unsigned* MISC = (volatile LAS unsigned*)(L + MISC_OFF);
    const int wave = __builtin_amdgcn_readfirstlane(threadIdx.x >> 6);
    const int G = gridDim.x, bx = blockIdx.x;
    const int gw = bx * NWAVES + wave, NGW = G * NWAVES;
    unsigned char* ws = a.ws;
    if (threadIdx.x < 32) MISC[threadIdx.x] = 0u;
    __syncthreads();
    XcdBarrier xbar = xcd_barrier_post((unsigned*)(ws + WS_CTL + 16384), MISC + 8);
    const float* x = a.in[I_X];
    bf16* WINT = (bf16*)(ws + WS_WIN); bf16* W1T = (bf16*)(ws + WS_W1T); bf16* W2T = (bf16*)(ws + WS_W2T);
    bf16* XN = (bf16*)(ws + WS_XN); bf16* QKC = XN;
    bf16* B0 = (bf16*)(ws + WS_B0); bf16* B1 = (bf16*)(ws + WS_B0 + WS_BSTR); bf16* B2 = (bf16*)(ws + WS_B0 + 2 * WS_BSTR); bf16* B3 = (bf16*)(ws + WS_B0 + 3 * WS_BSTR);
    bf16* B4 = (bf16*)(ws + WS_B0 + 4 * WS_BSTR); bf16* B5 = (bf16*)(ws + WS_B0 + 5 * WS_BSTR);
    bf16* HB = (bf16*)(ws + WS_H);
    bf16* WAT = (bf16*)(ws + WS_WAT); bf16* WMT = (bf16*)(ws + WS_WMT); bf16* WOT = (bf16*)(ws + WS_WOT);
    float* IFG = (float*)(ws + WS_IF);
    unsigned* CTL = (unsigned*)(ws + WS_CTL); float* RSQ1 = (float*)(ws + WS_CTL + 65536); float* RSQ2 = (float*)(ws + WS_CTL + 131072);
    bf16* GA = (bf16*)a.out; bf16* GM = GA + (size_t)TT * 1024;
    float* OUT = a.out;

    {
        const int tid = fresh_tid(wave), lane = tid & 63;
        LAS float* scr = (LAS float*)(L + wave * 8448);
        LAS float* WIF = (LAS float*)(L + 73728);
        const float* win = a.in[I_WIN];
        for (int i = tid; i < 8192; i += NTHR) WIF[(i & 7) * 1024 + (i >> 3)] = win[(size_t)(i >> 3) * DIN + 5120 + (i & 7)];
        for (int it = gw; it < 16 * 256; it += NGW) { const int kb = it >> 8, nb = it & 255; const int nd0 = 32 * nb, ns0 = nd0 + (nd0 >= 5120 ? 8 : 0);
            transpose_item(win, DIN, 1024, WINT, nd0, ns0, 64 * kb, nullptr, scr, lane); }
        __syncthreads();
        const float* gmix = a.in[I_NMIX]; const float* bg = a.in[I_BGATES];
        f32x4 gv[4];
#pragma unroll
        for (int j = 0; j < 4; ++j) gv[j] = *((const f32x4*)gmix + lane + 64 * j);
        f32x4 nx[4];
        if (gw < TT) {
#pragma unroll
            for (int j = 0; j < 4; ++j) nx[j] = __builtin_nontemporal_load((const f32x4*)(x + (size_t)gw * 1024) + lane + 64 * j); }
        for (int m = gw; m < TT; m += NGW) {
            f32x4 v[4]; float s = 0.f;
#pragma unroll
            for (int j = 0; j < 4; ++j) v[j] = nx[j];
            if (m + NGW < TT) {
#pragma unroll
                for (int j = 0; j < 4; ++j) nx[j] = __builtin_nontemporal_load((const f32x4*)(x + (size_t)(m + NGW) * 1024) + lane + 64 * j); }
#pragma unroll
            for (int j = 0; j < 4; ++j) s += (v[j].x * v[j].x + v[j].y * v[j].y) + (v[j].z * v[j].z + v[j].w * v[j].w);
            const float rstd = 1.f / sqrtf(wave_sum(s) * (1.f / 1024.f) + EPSN);
            float g8[8];
#pragma unroll
            for (int q = 0; q < 8; ++q) g8[q] = 0.f;
            unsigned long long* o8 = (unsigned long long*)(XN + (size_t)m * 1024) + lane;
#pragma unroll
            for (int j = 0; j < 4; ++j) { v[j] = v[j] * rstd * gv[j];
                o8[64 * j] = (unsigned long long)pk2(v[j].x, v[j].y) | ((unsigned long long)pk2(v[j].z, v[j].w) << 32);
#pragma unroll
                for (int q = 0; q < 8; ++q) { const f32x4 w = *(LAS const f32x4*)(WIF + q * 1024 + 256 * j + 4 * lane); g8[q] += (v[j][0] * w[0] + v[j][1] * w[1]) + (v[j][2] * w[2] + v[j][3] * w[3]); } }
            float mine = 0.f;
#pragma unroll
            for (int q = 0; q < 8; ++q) { const float sv = wave_sum(g8[q]); if (lane == q) mine = sv; }
            if (lane < 8) IFG[(size_t)m * 8 + lane] = mine + bg[lane];
        }
    }
    xcd_barrier(xbar);
    if (a.ws == nullptr) grid.sync();

    {
        pg8::Gemm g{XN, WINT, TT, 8192, 1024}; pg8::StaticOrder S; S.init(TT, 8192, G, bx);
        pg8::EpiProj E{B0, GA, (size_t)TT * 1024, a.in[I_BMERGE], attn_body::C2, a.in[I_MLNG], CTL + 12288};
        pg8::gemm_phase<pg8::EpiProj, pg8::StaticOrder, true, true>(L, g, S, E, wave);
    }
    xcd_barrier(xbar);


    {
        const int tid = fresh_tid(wave), lane = tid & 63;
        const float* cw = a.in[I_CONVW]; const float* cb = a.in[I_CONVB];
        const bf16* MLQK = B3;
#pragma unroll 2
        for (int it = bx * NTHR + tid; it < TT * 128; it += G * NTHR) {
            const int row = it >> 7, c0 = (it & 127) * 8, tp = row & (SEQ - 1);
            float acc[8];
            { const f32x4 b0 = *(const f32x4*)(cb + c0), b1 = *(const f32x4*)(cb + c0 + 4); acc[0] = b0[0]; acc[1] = b0[1]; acc[2] = b0[2]; acc[3] = b0[3]; acc[4] = b1[0]; acc[5] = b1[1]; acc[6] = b1[2]; acc[7] = b1[3]; }
#pragma unroll
            for (int j = 0; j < 4; ++j) if (tp - 3 + j >= 0) {
                const v4u u = *(const v4u*)(MLQK + (size_t)(row - 3 + j) * 1024 + c0); const f32x4 w0 = *(const f32x4*)(cw + j * 1024 + c0), w1 = *(const f32x4*)(cw + j * 1024 + c0 + 4);
                acc[0] += w0[0] * bflo(u.x); acc[1] += w0[1] * bfhi(u.x); acc[2] += w0[2] * bflo(u.y); acc[3] += w0[3] * bfhi(u.y);
                acc[4] += w1[0] * bflo(u.z); acc[5] += w1[1] * bfhi(u.z); acc[6] += w1[2] * bflo(u.w); acc[7] += w1[3] * bfhi(u.w); }
            const float sc = (c0 < 512) ? 0.08838834764831845f : 1.f;
#pragma unroll
            for (int i = 0; i < 8; ++i) acc[i] = acc[i] * pg8::sigm(acc[i]) * sc;
            v4u o; o.x = cvtpk(acc[0], acc[1]); o.y = cvtpk(acc[2], acc[3]); o.z = cvtpk(acc[4], acc[5]); o.w = cvtpk(acc[6], acc[7]);
            *(v4u*)(QKC + (size_t)row * 1024 + c0) = o;
        }
    }
    xcd_barrier(xbar);

    {
        const int tid = fresh_tid(wave), lane = tid & 63;
#ifndef NO_CHAIN
        if (bx < 16 * mls::NSEG) { const int bh = bx & 15, seg = bx >> 4; unsigned char* scr = ws + WS_B0 + 3 * WS_BSTR + 16 * MiB;
            mls::chain(L, bh >> 2, bh & 3, seg, QKC, B4, B5, IFG, a.in[I_MLNG], (f32x4*)scr + (size_t)bh * 4096, (float*)(scr + MiB) + (size_t)bh * (mls::NSEG - 1) * mls::ST_FLOATS, CTL + 8192 + bh * 16 * mls::NSEG, wave); }
#endif
        const float* lam = a.in[I_LAM]; float s1 = 0.f, s2 = 0.f;
        for (int k = 0; k < 64; ++k) { s1 += lam[k] * lam[64 + k]; s2 += lam[128 + k] * lam[192 + k]; }
        const float lamf = __expf(s1) - __expf(s2) + 0.2f;
        bf16* OT = B3 + (size_t)bx * (2 * 256 * 64);
        const float* dag = a.in[I_DANG];
        for (;;) {
            if (fresh_tid(wave) == 0) MISC[0] = atomicAdd(CTL, 1u);
            __syncthreads();
            const int item = __builtin_amdgcn_readfirstlane((int)MISC[0]);
            __syncthreads();
            if (item >= 512) break;
            const int code = ATT_ORDER[item];
            const int qb = code >> 5, b = (code >> 3) & 3, h = code & 7;
            const float sl2 = exp2f(-(float)(h + 1)) * 1.4426950408889634f;
            const size_t grow0 = (size_t)b * SEQ + (size_t)qb * 256;
            typedef attn_body::bf16 abf;
#ifndef NO_ATTN
#pragma unroll 1
            for (int m = 0; m < 2; ++m) {
                int t0 = 0;
                { const unsigned* np_ = CTL + 12288 + (b * 16 + 2 * h + m) * 4;
                  const float bq2 = __uint_as_float(__hip_atomic_load(np_ + 0, __ATOMIC_RELAXED, __HIP_MEMORY_SCOPE_AGENT)) + __uint_as_float(__hip_atomic_load(np_ + 1, __ATOMIC_RELAXED, __HIP_MEMORY_SCOPE_AGENT));
                  const float bk2 = __uint_as_float(__hip_atomic_load(np_ + 2, __ATOMIC_RELAXED, __HIP_MEMORY_SCOPE_AGENT)) + __uint_as_float(__hip_atomic_load(np_ + 3, __ATOMIC_RELAXED, __HIP_MEMORY_SCOPE_AGENT));
                  const float dmin = (152.f + 2.02f * sqrtf(bq2 * bk2)) / sl2;
                  const float tf = floorf(((float)(qb * 256 + 1) - dmin) * (1.f / 64.f));
                  int ti = tf > 0.f ? (int)tf : 0; if (ti > 4 * qb) ti = 4 * qb; t0 = __builtin_amdgcn_readfirstlane(ti & ~1); }
                if (m == 0) attn_body::attn_unit<96>(b, 2 * h, h * 128, qb, t0, sl2, (const abf*)B0, (const abf*)B1, (const abf*)B2, (abf*)OT, 128, (char*)lds, wave);
                else        attn_body::attn_unit<96>(b, 2 * h + 1, h * 128, qb, t0, sl2, (const abf*)B0, (const abf*)B1, (const abf*)B2, (abf*)(B0 + grow0 * 1024 + h * 128), 1024, (char*)lds, wave);
            }
#endif
            asm volatile("s_waitcnt vmcnt(0)" ::: "memory");
            __syncthreads();
#ifndef NO_COMB
            {
                const int tidc = fresh_tid(wave); const int row = tidc >> 1, j = tidc & 1; const size_t grow = grow0 + row;
                const bf16* p0 = OT + row * 128 + 64 * j;
                const bf16* p1 = B0 + grow * 1024 + h * 128 + 64 * j;
                float av[64]; float ss = 0.f;
#pragma unroll
                for (int c8 = 0; c8 < 8; ++c8) { const v4u u0 = *(const v4u*)(p0 + 8 * c8), u1 = *(const v4u*)(p1 + 8 * c8);
                    av[8 * c8 + 0] = bflo(u0.x) - lamf * bflo(u1.x); av[8 * c8 + 1] = bfhi(u0.x) - lamf * bfhi(u1.x); av[8 * c8 + 2] = bflo(u0.y) - lamf * bflo(u1.y); av[8 * c8 + 3] = bfhi(u0.y) - lamf * bfhi(u1.y);
                    av[8 * c8 + 4] = bflo(u0.z) - lamf * bflo(u1.z); av[8 * c8 + 5] = bfhi(u0.z) - lamf * bfhi(u1.z); av[8 * c8 + 6] = bflo(u0.w) - lamf * bflo(u1.w); av[8 * c8 + 7] = bfhi(u0.w) - lamf * bfhi(u1.w); }
#pragma unroll
                for (int i = 0; i < 64; ++i) ss += av[i] * av[i];
                ss += sx(ss, 1);
                const float rs = __builtin_amdgcn_rsqf(ss * (1.f / 128.f) + EPSN) * 0.8f;
                bf16* dst = B0 + grow * 1024 + h * 128 + 64 * j; const float* gp = dag + h * 128 + 64 * j;
#pragma unroll
                for (int c8 = 0; c8 < 8; ++c8) { const f32x4 g0 = *(const f32x4*)(gp + 8 * c8), g1 = *(const f32x4*)(gp + 8 * c8 + 4); v4u o;
                    o.x = cvtpk(av[8 * c8 + 0] * rs * g0[0], av[8 * c8 + 1] * rs * g0[1]); o.y = cvtpk(av[8 * c8 + 2] * rs * g0[2], av[8 * c8 + 3] * rs * g0[3]);
                    o.z = cvtpk(av[8 * c8 + 4] * rs * g1[0], av[8 * c8 + 5] * rs * g1[1]); o.w = cvtpk(av[8 * c8 + 6] * rs * g1[2], av[8 * c8 + 7] * rs * g1[3]);
                    *(v4u*)(dst + 8 * c8) = o; }
            }
#endif
            asm volatile("s_waitcnt vmcnt(0)" ::: "memory");
            __syncthreads();
        }
        {
            LAS float* scr = (LAS float*)(L + wave * 8448);
            for (;;) {
                if (tid == 0) MISC[0] = atomicAdd(CTL + 32, 1u);
                __syncthreads();
                const int wi = __builtin_amdgcn_readfirstlane((int)MISC[0]);
                __syncthreads();
                if (wi >= 704) break;
                int r = wi * 8 + wave;
                if (r < 512) { transpose_item(a.in[I_WA], 1024, 1024, WAT, 32 * (r & 31), 32 * (r & 31), 64 * (r >> 5), nullptr, scr, lane); continue; } r -= 512;
                if (r < 512) { transpose_item(a.in[I_WM], 1024, 1024, WMT, 32 * (r & 31), 32 * (r & 31), 64 * (r >> 5), nullptr, scr, lane); continue; } r -= 512;
                if (r < 512) { transpose_item(a.in[I_WOUT], 1024, 1024, WOT, 32 * (r & 31), 32 * (r & 31), 64 * (r >> 5), nullptr, scr, lane); continue; } r -= 512;
                if (r < 2048) { transpose_item(a.in[I_WFF1], 4096, 1024, W1T, 32 * (r & 127), 32 * (r & 127), 64 * (r >> 7), a.in[I_NMLP], scr, lane); continue; } r -= 2048;
                transpose_item(a.in[I_WFF2], 1024, 4096, W2T, 32 * (r & 31), 32 * (r & 31), 64 * (r >> 5), nullptr, scr, lane);
            }
        }
    }
    xcd_barrier(xbar);

    {
        pg8::StaticOrder S; S.init(TT, 1024, G, bx);
        { pg8::Gemm g{B0, WAT, TT, 1024, 1024}; pg8::EpiGate<false> E{GA, nullptr, B1}; pg8::gemm_phase<pg8::EpiGate<false>, pg8::StaticOrder, true, true>(L, g, S, E, wave); }
        { pg8::Gemm g{B4, WMT, TT, 1024, 1024}; pg8::EpiGate<true> E{GM, B1, B2}; pg8::gemm_phase<pg8::EpiGate<true>, pg8::StaticOrder, true, true>(L, g, S, E, wave); }
    }
    xcd_barrier(xbar);

    {
        pg8::Gemm g{B2, WOT, TT, 1024, 1024}; pg8::StaticOrder S; S.init(TT, 1024, G, bx);
        pg8::EpiRes E{x, (G == 256) ? nullptr : OUT, B5, RSQ1};
        pg8::gemm_phase<pg8::EpiRes, pg8::StaticOrder, true, true>(L, g, S, E, wave);
    }
    xcd_barrier(xbar);

    {
        pg8::Gemm g{B5, W1T, TT, 4096, 1024}; pg8::StaticOrder S; S.init(TT, 4096, G, bx);
        pg8::EpiFF1 E{HB, RSQ1, EPSN};
        pg8::gemm_phase<pg8::EpiFF1, pg8::StaticOrder, true, true>(L, g, S, E, wave);
    }
    xcd_barrier(xbar);

    if (G == 256) {
        pg8::Gemm g{HB, W2T, TT, 1024, 4096}; pg8::StaticOrder S; S.init(TT, 1024, G, bx);
        pg8::EpiFinal E{B5, OUT, a.in[I_NFIN], (float*)(ws + WS_CTL + CTL_BYTES), CTL + 49152, EPSN};
        pg8::gemm_phase<pg8::EpiFinal, pg8::StaticOrder, false, true>(L, g, S, E, wave);
    } else {
    {
        pg8::Gemm g{HB, W2T, TT, 1024, 4096}; pg8::StaticOrder S; S.init(TT, 1024, G, bx);
        pg8::EpiRes E{OUT, OUT, nullptr, RSQ2};
        pg8::gemm_phase<pg8::EpiRes, pg8::StaticOrder, true, true>(L, g, S, E, wave);
    }
    xcd_barrier(xbar);

    {
        const int tid = fresh_tid(wave), lane = tid & 63;
        const float* gf = a.in[I_NFIN];
        f32x4 gv[4];
#pragma unroll
        for (int j = 0; j < 4; ++j) gv[j] = *((const f32x4*)gf + lane + 64 * j);
        for (int m = gw; m < TT; m += 2 * NGW) {
            const int m2 = m + NGW; const bool has2 = m2 < TT;
            const float rs = __builtin_amdgcn_rsqf(RSQ2[m] * (1.f / 1024.f) + EPSN), rs2 = has2 ? __builtin_amdgcn_rsqf(RSQ2[m2] * (1.f / 1024.f) + EPSN) : 0.f;
            f32x4* xr = (f32x4*)(OUT + (size_t)m * 1024) + lane; f32x4* xr2 = (f32x4*)(OUT + (size_t)(has2 ? m2 : m) * 1024) + lane;
            f32x4 a0[4], a1[4];
#pragma unroll
            for (int j = 0; j < 4; ++j) { a0[j] = xr[64 * j]; a1[j] = xr2[64 * j]; }
#pragma unroll
            for (int j = 0; j < 4; ++j) { xr[64 * j] = a0[j] * rs * gv[j]; if (has2) xr2[64 * j] = a1[j] * rs2 * gv[j]; }
        }
    }
    }
}

extern "C" void kernel_launch(void* const* d_in, const int* in_sizes, int n_in, void* d_out, int out_size, void* d_ws, size_t ws_size, hipStream_t stream) {
    static int grid = 0;
    if (grid == 0) {
        if (n_in != 17 || out_size != TT * 1024 || ws_size < WS_END) { fprintf(stderr, "kernel_launch: unexpected shapes (n_in %d, out %d, ws %zu)\n", n_in, out_size, ws_size); grid = -1; return; }
        int dev = 0, cus = 0, per_cu = 0;
        hipGetDevice(&dev); hipDeviceGetAttribute(&cus, hipDeviceAttributeMultiprocessorCount, dev);
        if (hipFuncSetAttribute((const void*)mk_fwd, hipFuncAttributeMaxDynamicSharedMemorySize, LDS_BYTES) != hipSuccess) { fprintf(stderr, "kernel_launch: hipFuncSetAttribute failed\n"); grid = -1; return; }
        if (hipOccupancyMaxActiveBlocksPerMultiprocessor(&per_cu, (const void*)mk_fwd, NTHR, LDS_BYTES) != hipSuccess || per_cu < 1) { fprintf(stderr, "kernel_launch: occupancy query gave %d\n", per_cu); per_cu = 1; }
        (void)hipGetLastError();
        grid = cus * per_cu;
    }
    if (grid < 0) return;
    hipMemsetAsync((char*)d_ws + WS_CTL, 0, CTL_BYTES, stream);
    Args a{};
    for (int i = 0; i < 17; ++i) a.in[i] = (const float*)d_in[i];
    a.out = (float*)d_out; a.ws = (unsigned char*)d_ws;
    void* args[] = {&a};
    hipError_t e = hipLaunchCooperativeKernel((const void*)mk_fwd, dim3(grid), dim3(NTHR), args, LDS_BYTES, stream);
    if (e != hipSuccess) fprintf(stderr, "kernel_launch: cooperative launch failed: %s (grid %d)\n", hipGetErrorString(e), grid);
}
```

```cpp
#include <hip/hip_runtime.h>
#include <hip/hip_cooperative_groups.h>
#include <cstdio>
#include <cstdint>
namespace cg = cooperative_groups;
__device__ __forceinline__ int my_lane() { int l_; asm volatile("v_mbcnt_lo_u32_b32 %0, -1, 0\n\tv_mbcnt_hi_u32_b32 %0, -1, %0" : "=v"(l_)); return l_; }
__device__ __forceinline__ int fresh_tid(int wave_s) { return wave_s * 64 + my_lane(); }
__device__ __forceinline__ float sx(float v, int m) { return __builtin_bit_cast(float, __builtin_amdgcn_ds_bpermute((my_lane() ^ m) << 2, __builtin_bit_cast(int, v))); }
namespace pg8 {
#define PG8_LAS __attribute__((address_space(3)))
typedef unsigned short bf16_t;
typedef short bf16x8 __attribute__((ext_vector_type(8)));
typedef float f32x4 __attribute__((ext_vector_type(4)));
typedef unsigned u32x4 __attribute__((ext_vector_type(4)));
constexpr int BM = 256, BK = 64, HALF = 128, HTB = HALF * BK * 2  , STAGE_BYTES = 8 * HTB, NXCD = 8, WGM = 8;

__host__ __device__ __forceinline__ int lds_byte(int r, int c) { const int st = (r >> 4) * 2 + (c >> 5), rr = r & 15, cc = c & 31, ob = rr * 64 + cc * 2; return st * 1024 + (ob ^ (((ob >> 9) & 1) << 5)); }
__host__ __device__ __forceinline__ void stage_rc(int b, int& R, int& C) { const int st = b / 1024, sb = b % 1024, swz = sb ^ (((sb >> 9) & 1) << 5); R = (st >> 1) * 16 + swz / 64; C = (st & 1) * 32 + (swz % 64) / 2; }
__host__ __device__ __forceinline__ int perm32(int rho) { const int n = rho >> 4, i = rho & 15; return 8 * (i >> 2) + 4 * n + (i & 3); }

struct Unit { int pm, pn; };
struct Gemm { const bf16_t* A; const bf16_t* Bt; int M, N, K; };

struct StaticOrder {
    int nM, nN, nwg, G, c;
    __host__ __device__ void init(int M, int N, int G_, int c_) { nM = M / BM; nN = N / BM; nwg = nM * nN; G = G_; c = c_; }
    __host__ __device__ bool next(int i, Unit& u) const {
        const long L = (long)i * G + c; if (L >= nwg) return false;
        int wgid = (int)L; { const int q = nwg / NXCD, r = nwg % NXCD, xcd = wgid % NXCD, off = wgid / NXCD; wgid = (xcd < r ? xcd * (q + 1) : r * (q + 1) + (xcd - r) * q) + off; }
        const int nig = WGM * nN, gid = wgid / nig, fm = gid * WGM, gsz = (nM - fm) < WGM ? (nM - fm) : WGM;
        u.pm = fm + ((wgid % nig) % gsz); u.pn = (wgid % nig) / gsz; return true;
    }
    __device__ __forceinline__ void a_ready(const Unit&) const {}
    __device__ __forceinline__ void done(const Unit&) const {}
};

__device__ __forceinline__ unsigned cvt_pk_bf16(float lo, float hi) { unsigned r; asm volatile("v_cvt_pk_bf16_f32 %0, %1, %2" : "=v"(r) : "v"(lo), "v"(hi)); return r; }
typedef float f32x2 __attribute__((ext_vector_type(2)));
typedef unsigned u32x2 __attribute__((ext_vector_type(2)));
__device__ __forceinline__ float bf_lo(unsigned w) { return __uint_as_float(w << 16); }
__device__ __forceinline__ float bf_hi(unsigned w) { return __uint_as_float(w & 0xffff0000u); }
__device__ __forceinline__ float sigm(float v) { return __builtin_amdgcn_rcpf(1.f + __expf(-v)); }

struct EpiProj {
    static constexpr bool PERM = true, AFTER_DRAIN = false;
    bf16_t* wsb; bf16_t* outb; size_t stride; const float* bmerge; float scale0; const float* mlng; unsigned* nmax;
    __device__ __forceinline__ void operator()(const f32x4 (&acc)[2][2][4][2], const Unit& u, int wr, int wc, int fr, int fq) const {
        const int row0 = u.pm * BM + wr * 64 + fr; int colt = u.pn * BM; const int t = colt >> 10; colt &= 1023;
        bf16_t* base = (t < 6) ? wsb + (size_t)t * stride : outb + (size_t)(t - 6) * stride;
        const float sc = (t == 0) ? scale0 : 1.f; const bool gate = (t >= 6);
        const int col0 = colt + wc * 32 + 8 * fq;
        f32x4 bv[2][2];
#pragma unroll
        for (int bj = 0; bj < 2; ++bj)
#pragma unroll
            for (int n = 0; n < 2; ++n) bv[bj][n] = gate ? *(const f32x4*)(bmerge + (t - 6) * 1024 + col0 + bj * HALF + 4 * n) : (f32x4){0.f, 0.f, 0.f, 0.f};
        float pmax[2] = {0.f, 0.f};
#pragma unroll
        for (int ai = 0; ai < 2; ++ai)
#pragma unroll
            for (int m = 0; m < 4; ++m) { bf16_t* rowp = base + (size_t)(row0 + ai * HALF + m * 16) * 1024 + col0;
#pragma unroll
                for (int bj = 0; bj < 2; ++bj) { f32x4 v0 = acc[ai][bj][m][0] + bv[bj][0], v1 = acc[ai][bj][m][1] + bv[bj][1];
                    if (gate || t == 5) { v0 = (f32x4){sigm(v0[0]), sigm(v0[1]), sigm(v0[2]), sigm(v0[3])}; v1 = (f32x4){sigm(v1[0]), sigm(v1[1]), sigm(v1[2]), sigm(v1[3])}; }
                    if (t == 5) { v0 = v0 * *(const f32x4*)(mlng + col0 + bj * HALF); v1 = v1 * *(const f32x4*)(mlng + col0 + bj * HALF + 4); }
                    v0 = v0 * sc; v1 = v1 * sc; u32x4 w; w.x = cvt_pk_bf16(v0[0], v0[1]); w.y = cvt_pk_bf16(v0[2], v0[3]); w.z = cvt_pk_bf16(v1[0], v1[1]); w.w = cvt_pk_bf16(v1[2], v1[3]);
                    *(u32x4*)(rowp + bj * HALF) = w;
                    if (t < 2) { float ss = (v0[0] * v0[0] + v0[1] * v0[1]) + (v0[2] * v0[2] + v0[3] * v0[3]) + (v1[0] * v1[0] + v1[1] * v1[1]) + (v1[2] * v1[2] + v1[3] * v1[3]);
                        ss += sx(ss, 16); ss += sx(ss, 32); pmax[bj] = fmaxf(pmax[bj], ss); } } }
        if (t < 2) {
#pragma unroll
            for (int bj = 0; bj < 2; ++bj) { float p = pmax[bj]; p = fmaxf(p, sx(p, 1)); p = fmaxf(p, sx(p, 2)); p = fmaxf(p, sx(p, 4)); p = fmaxf(p, sx(p, 8));
                if (fr == 0 && fq == 0) { const int bb_ = (u.pm * BM) >> 12, hm_ = (colt >> 6) + 2 * bj + (wc >> 1); atomicMax(nmax + (((bb_ * 16 + hm_) * 2 + t) * 2 + (wc & 1)), __float_as_uint(p)); } }
        }
    }
};
template <bool ADD> struct EpiGate {
    static constexpr bool PERM = true, AFTER_DRAIN = false;
    const bf16_t* g; const bf16_t* prev; bf16_t* O;
    __device__ __forceinline__ void operator()(const f32x4 (&acc)[2][2][4][2], const Unit& u, int wr, int wc, int fr, int fq) const {
        const int row0 = u.pm * BM + wr * 64 + fr; const int col0 = u.pn * BM + wc * 32 + 8 * fq;
#pragma unroll
        for (int ai = 0; ai < 2; ++ai) {
            u32x4 gw[4][2], pw[4][2];
#pragma unroll
            for (int m = 0; m < 4; ++m)
#pragma unroll
                for (int bj = 0; bj < 2; ++bj) { const size_t off = (size_t)(row0 + ai * HALF + m * 16) * 1024 + col0 + bj * HALF;
                    gw[m][bj] = *(const u32x4*)(g + off); if (ADD) pw[m][bj] = *(const u32x4*)(prev + off); }
            asm volatile("" ::: "memory");
#pragma unroll
            for (int m = 0; m < 4; ++m)
#pragma unroll
                for (int bj = 0; bj < 2; ++bj) { const size_t off = (size_t)(row0 + ai * HALF + m * 16) * 1024 + col0 + bj * HALF; const u32x4 gq = gw[m][bj];
                    f32x4 v0 = acc[ai][bj][m][0], v1 = acc[ai][bj][m][1];
                    v0 = v0 * (f32x4){bf_lo(gq.x), bf_hi(gq.x), bf_lo(gq.y), bf_hi(gq.y)}; v1 = v1 * (f32x4){bf_lo(gq.z), bf_hi(gq.z), bf_lo(gq.w), bf_hi(gq.w)};
                    if (ADD) { const u32x4 pq = pw[m][bj];
                        v0 = v0 + (f32x4){bf_lo(pq.x), bf_hi(pq.x), bf_lo(pq.y), bf_hi(pq.y)}; v1 = v1 + (f32x4){bf_lo(pq.z), bf_hi(pq.z), bf_lo(pq.w), bf_hi(pq.w)}; }
                    u32x4 w; w.x = cvt_pk_bf16(v0[0], v0[1]); w.y = cvt_pk_bf16(v0[2], v0[3]); w.z = cvt_pk_bf16(v1[0], v1[1]); w.w = cvt_pk_bf16(v1[2], v1[3]);
                    *(u32x4*)(O + off) = w; }
            asm volatile("" ::: "memory");
        }
    }
};
struct EpiRes {
    static constexpr bool PERM = false, AFTER_DRAIN = false;
    const float* base; float* out; bf16_t* outb; float* rsq;
    __device__ __forceinline__ void operator()(const f32x4 (&acc)[2][2][4][2], const Unit& u, int wr, int wc, int fr, int fq) const {
        const int col0 = u.pn * BM + wc * 32 + 4 * fq;
#pragma unroll
        for (int ai = 0; ai < 2; ++ai) {
            f32x4 bs[4][2][2];
#pragma unroll
            for (int m = 0; m < 4; ++m) { const size_t off = (size_t)(u.pm * BM + ai * HALF + wr * 64 + m * 16 + fr) * 1024 + col0;
#pragma unroll
                for (int bj = 0; bj < 2; ++bj)
#pragma unroll
                    for (int n = 0; n < 2; ++n) bs[m][bj][n] = *(const f32x4*)(base + off + bj * HALF + n * 16); }
            asm volatile("" ::: "memory");
#pragma unroll
            for (int m = 0; m < 4; ++m) { const int row = u.pm * BM + ai * HALF + wr * 64 + m * 16 + fr; const size_t off = (size_t)row * 1024 + col0; float ss = 0.f;
#pragma unroll
                for (int bj = 0; bj < 2; ++bj)
#pragma unroll
                    for (int n = 0; n < 2; ++n) { const f32x4 v = bs[m][bj][n] + acc[ai][bj][m][n];
                        if (out) *(f32x4*)(out + off + bj * HALF + n * 16) = v;
                        if (outb) { u32x2 w; w.x = cvt_pk_bf16(v[0], v[1]); w.y = cvt_pk_bf16(v[2], v[3]); *(u32x2*)(outb + off + bj * HALF + n * 16) = w; }
                        ss += (v[0] * v[0] + v[1] * v[1]) + (v[2] * v[2] + v[3] * v[3]); }
                ss += sx(ss, 16); ss += sx(ss, 32);
                if (fq == 0) atomicAdd(rsq + row, ss); }
            asm volatile("" ::: "memory");
        }
    }
};
struct EpiFinal {
    static constexpr bool PERM = false, AFTER_DRAIN = true;
    const bf16_t* base; float* out; const float* gain; float* xbuf; unsigned* cnt; float eps;
    __device__ __forceinline__ void fused(f32x4 (&acc)[2][2][4][2], const Unit& u, int wr, int wc, int fr, int fq, PG8_LAS unsigned char* lds, int wid, int lane) const {
        PG8_LAS float* P = (PG8_LAS float*)lds;
        PG8_LAS float* S = (PG8_LAS float*)(lds + 4096);
        PG8_LAS unsigned* flag = (PG8_LAS unsigned*)(lds + 5120);
        const int col0 = u.pn * BM + wc * 32 + 4 * fq;
#pragma unroll
        for (int ai = 0; ai < 2; ++ai)
#pragma unroll
            for (int m = 0; m < 4; ++m) { const int rl = ai * HALF + wr * 64 + m * 16 + fr; const size_t off = (size_t)(u.pm * BM + rl) * 1024 + col0; float ss = 0.f;
#pragma unroll
                for (int bj = 0; bj < 2; ++bj)
#pragma unroll
                    for (int n = 0; n < 2; ++n) { const u32x2 bw = *(const u32x2*)(base + off + bj * HALF + n * 16); const f32x4 bs = {bf_lo(bw.x), bf_hi(bw.x), bf_lo(bw.y), bf_hi(bw.y)}; const f32x4 v = bs + acc[ai][bj][m][n]; acc[ai][bj][m][n] = v;
                        ss += (v[0] * v[0] + v[1] * v[1]) + (v[2] * v[2] + v[3] * v[3]); }
                ss += sx(ss, 16); ss += sx(ss, 32);
                if (fq == 0) P[rl * 4 + wc] = ss;
                if (m & 1) asm volatile("" ::: "memory"); }
        asm volatile("s_waitcnt lgkmcnt(0)" ::: "memory"); __builtin_amdgcn_s_barrier(); asm volatile("" ::: "memory");
        const int row = wid * 32 + (lane & 31);
        if (lane < 32) { const f32x4 p4 = *(PG8_LAS const f32x4*)(P + row * 4); const float s = (p4[0] + p4[1]) + (p4[2] + p4[3]);
            __hip_atomic_store(xbuf + (size_t)(u.pm * BM + row) * 4 + u.pn, s, __ATOMIC_RELAXED, __HIP_MEMORY_SCOPE_AGENT); }
        asm volatile("s_waitcnt vmcnt(0)" ::: "memory");
        if (lane == 0) __hip_atomic_fetch_add(cnt + 64 * u.pm, 1u, __ATOMIC_RELAXED, __HIP_MEMORY_SCOPE_AGENT);
        if (wid == 0) {
            unsigned sp = 0;
            while ((unsigned)__builtin_amdgcn_readfirstlane(__hip_atomic_load(cnt + 64 * u.pm, __ATOMIC_RELAXED, __HIP_MEMORY_SCOPE_AGENT)) < 32u && ++sp < (1u << 22)) __builtin_amdgcn_s_sleep(2);
            __builtin_amdgcn_fence(__ATOMIC_ACQUIRE, "agent");
            if (lane == 0) flag[0] = 1u;
        }
        asm volatile("s_waitcnt vmcnt(0) lgkmcnt(0)" ::: "memory"); __builtin_amdgcn_s_barrier(); asm volatile("" ::: "memory");
        if (lane < 32) { const float* sl = xbuf + (size_t)(u.pm * BM + row) * 4; float t = 0.f;
#pragma unroll
            for (int q = 0; q < 4; ++q) t += __hip_atomic_load(sl + q, __ATOMIC_RELAXED, __HIP_MEMORY_SCOPE_AGENT);
            S[row] = __builtin_amdgcn_rsqf(t * (1.f / 1024.f) + eps); }
        asm volatile("s_waitcnt lgkmcnt(0)" ::: "memory"); __builtin_amdgcn_s_barrier(); asm volatile("" ::: "memory");
        f32x4 gv[2][2];
#pragma unroll
        for (int bj = 0; bj < 2; ++bj)
#pragma unroll
            for (int n = 0; n < 2; ++n) gv[bj][n] = *(const f32x4*)(gain + col0 + bj * HALF + n * 16);
#pragma unroll
        for (int ai = 0; ai < 2; ++ai)
#pragma unroll
            for (int m = 0; m < 4; ++m) { const int rl = ai * HALF + wr * 64 + m * 16 + fr; const float rs = S[rl]; const size_t off = (size_t)(u.pm * BM + rl) * 1024 + col0;
#pragma unroll
                for (int bj = 0; bj < 2; ++bj)
#pragma unroll
                    for (int n = 0; n < 2; ++n) *(f32x4*)(out + off + bj * HALF + n * 16) = acc[ai][bj][m][n] * rs * gv[bj][n]; }
    }
};
struct EpiFF1 {
    static constexpr bool PERM = true, AFTER_DRAIN = false;
    bf16_t* O; const float* rsq; float eps;
    __device__ __forceinline__ void operator()(const f32x4 (&acc)[2][2][4][2], const Unit& u, int wr, int wc, int fr, int fq) const {
        const int row0 = u.pm * BM + wr * 64 + fr; const int col0 = u.pn * BM + wc * 32 + 8 * fq;
#pragma unroll
        for (int ai = 0; ai < 2; ++ai)
#pragma unroll
            for (int m = 0; m < 4; ++m) { const int row = row0 + ai * HALF + m * 16; const float rs = __builtin_amdgcn_rsqf(rsq[row] * (1.f / 1024.f) + eps);
                bf16_t* rowp = O + (size_t)row * 4096 + col0;
#pragma unroll
                for (int bj = 0; bj < 2; ++bj) { f32x4 v0 = acc[ai][bj][m][0] * rs, v1 = acc[ai][bj][m][1] * rs;
#pragma unroll
                    for (int i = 0; i < 4; ++i) { float a = fmaxf(v0[i], 0.f), b = fmaxf(v1[i], 0.f); v0[i] = a * a; v1[i] = b * b; }
                    u32x4 w; w.x = cvt_pk_bf16(v0[0], v0[1]); w.y = cvt_pk_bf16(v0[2], v0[3]); w.z = cvt_pk_bf16(v1[0], v1[1]); w.w = cvt_pk_bf16(v1[2], v1[3]);
                    *(u32x4*)(rowp + bj * HALF) = w; } }
    }
};
template <class Epi, class Sched, bool ALIGN_EPI = false, bool SP2 = false>
__device__ __forceinline__ void gemm_phase(PG8_LAS unsigned char* lds, const Gemm g, const Sched& S, const Epi& E, const int wave_s) {
    const int tid = fresh_tid(wave_s), wid = __builtin_amdgcn_readfirstlane(tid >> 6), lane = tid & 63, wr = wid >> 2, wc = wid & 3, fr = lane & 15, fq = lane >> 4;
    const int K = g.K, nt = K / BK;
    unsigned voffA[2], voffB[2];
#pragma unroll
    for (int i = 0; i < 2; ++i) { int R, C; stage_rc(tid * 16 + i * 8192, R, C); const int Rb = Epi::PERM ? ((R & ~31) + perm32(R & 31)) : R;
        voffA[i] = (unsigned)(R * K + C) * 2u; voffB[i] = (unsigned)(Rb * K + C) * 2u; }
    const size_t kstep = (size_t)(BK * 2);
    const size_t hstep = (size_t)HALF * K * 2;
    const size_t tstep = 2 * hstep;
    const unsigned ldsw = (unsigned)wid * 1024u;
    const int aoff = lds_byte(wr * 64 + fr, fq * 8), boff = lds_byte(wc * 32 + fr, fq * 8);
#define PG8_SA(b, h) (((b) * 2 + (h)) * HTB)
#define PG8_SB(b, h) ((4 + (b) * 2 + (h)) * HTB)
#define PG8_STAGE(bufoff, gbase, voff) do { _Pragma("unroll") for (int _i = 0; _i < 2; ++_i) \
        __builtin_amdgcn_global_load_lds((const unsigned*)((const char*)(gbase) + (voff)[_i]), (PG8_LAS unsigned*)(lds + (bufoff) + ldsw + _i * 8192), 16, 0, 0); } while (0)
#define PG8_LDA(dst, b, h) do { _Pragma("unroll") for (int m = 0; m < 4; ++m) _Pragma("unroll") for (int k = 0; k < 2; ++k) dst[m][k] = *(const PG8_LAS bf16x8*)(lds + PG8_SA(b, h) + aoff + m * 2048 + k * 1024); } while (0)
#define PG8_LDB(dst, b, h) do { _Pragma("unroll") for (int n = 0; n < 2; ++n) _Pragma("unroll") for (int k = 0; k < 2; ++k) dst[n][k] = *(const PG8_LAS bf16x8*)(lds + PG8_SB(b, h) + boff + n * 2048 + k * 1024); } while (0)
#define PG8_MMA(ai, bj, At, Bt) do { __builtin_amdgcn_s_setprio(1); _Pragma("unroll") for (int m = 0; m < 4; ++m) _Pragma("unroll") for (int n = 0; n < 2; ++n) _Pragma("unroll") for (int k = 0; k < 2; ++k) \
        acc[ai][bj][m][n] = __builtin_amdgcn_mfma_f32_16x16x32_bf16(Bt[n][k], At[m][k], acc[ai][bj][m][n], 0, 0, 0); __builtin_amdgcn_s_setprio(0); } while (0)
#define PG8_WAIT_V(n) asm volatile("s_waitcnt vmcnt(" #n ")" ::: "memory")
#define PG8_WAIT_L(n) asm volatile("s_waitcnt lgkmcnt(" #n ")" ::: "memory")
#define PG8_BAR __builtin_amdgcn_s_barrier()
#define PG8_SCHED __builtin_amdgcn_sched_barrier(0)
    Unit cur, nxt; int ui = 0;
    if (!S.next(0, cur)) return;
    f32x4 acc[2][2][4][2];
#pragma unroll
    for (int a = 0; a < 2; ++a)
#pragma unroll
        for (int b = 0; b < 2; ++b)
#pragma unroll
            for (int m = 0; m < 4; ++m)
#pragma unroll
                for (int n = 0; n < 2; ++n) acc[a][b][m][n] = (f32x4){0.f, 0.f, 0.f, 0.f};
    bf16x8 At[4][2], B0[2][2], B1[2][2];
    const char* cA = (const char*)g.A + (size_t)cur.pm * tstep; const char* cB = (const char*)g.Bt + (size_t)cur.pn * tstep;
    S.a_ready(cur);
    if constexpr (SP2) {
        PG8_STAGE(PG8_SB(0, 0), cB, voffB); PG8_STAGE(PG8_SB(0, 1), cB + hstep, voffB); PG8_STAGE(PG8_SA(0, 0), cA, voffA); PG8_STAGE(PG8_SA(0, 1), cA + hstep, voffA);
        if (wr == 1) PG8_BAR;
        PG8_WAIT_V(2); PG8_BAR;
        PG8_STAGE(PG8_SB(1, 0), cB + kstep, voffB); PG8_STAGE(PG8_SA(1, 0), cA + kstep, voffA); PG8_STAGE(PG8_SB(1, 1), cB + hstep + kstep, voffB);
        PG8_WAIT_V(6); PG8_BAR;
    } else {
        PG8_STAGE(PG8_SB(0, 0), cB, voffB); PG8_STAGE(PG8_SA(0, 0), cA, voffA); PG8_STAGE(PG8_SB(0, 1), cB + hstep, voffB); PG8_STAGE(PG8_SA(0, 1), cA + hstep, voffA);
        if (wr == 1) PG8_BAR;
        PG8_WAIT_V(4); PG8_BAR;
        PG8_STAGE(PG8_SB(1, 0), cB + kstep, voffB); PG8_STAGE(PG8_SA(1, 0), cA + kstep, voffA); PG8_STAGE(PG8_SB(1, 1), cB + hstep + kstep, voffB);
        PG8_WAIT_V(6); PG8_BAR;
    }
    for (;;) {
        const bool has_next = S.next(ui + 1, nxt);
        const char* nA = has_next ? (const char*)g.A + (size_t)nxt.pm * tstep : cA; const char* nB = has_next ? (const char*)g.Bt + (size_t)nxt.pn * tstep : cB;
        for (int t = 0; t < nt; t += 2) {
            const bool last = (t == nt - 2);
            const char* a1 = cA + (size_t)(t + 1) * kstep;
            const char* a2 = last ? nA : cA + (size_t)(t + 2) * kstep; const char* b2 = last ? nB : cB + (size_t)(t + 2) * kstep;
            const char* a3 = a2 + kstep; const char* b3 = b2 + kstep;
            if (last && has_next) S.a_ready(nxt);
            if constexpr (SP2) {
            PG8_LDB(B0, 0, 0); PG8_LDB(B1, 0, 1); PG8_SCHED; PG8_LDA(At, 0, 0); PG8_STAGE(PG8_SA(1, 1), a1 + hstep, voffA);
            PG8_WAIT_V(8); PG8_WAIT_L(0); PG8_BAR; PG8_MMA(0, 0, At, B0); PG8_MMA(0, 1, At, B1); PG8_BAR; PG8_SCHED;
            PG8_LDA(At, 0, 1); PG8_STAGE(PG8_SB(0, 0), b2, voffB); PG8_STAGE(PG8_SB(0, 1), b2 + hstep, voffB); PG8_STAGE(PG8_SA(0, 0), a2, voffA);
            PG8_WAIT_V(8); PG8_WAIT_L(0); PG8_BAR; PG8_MMA(1, 0, At, B0); PG8_MMA(1, 1, At, B1); PG8_BAR; PG8_SCHED;
            PG8_LDB(B0, 1, 0); PG8_LDB(B1, 1, 1); PG8_SCHED; PG8_LDA(At, 1, 0); PG8_STAGE(PG8_SA(0, 1), a2 + hstep, voffA);
            PG8_WAIT_V(8); PG8_WAIT_L(0); PG8_BAR; PG8_MMA(0, 0, At, B0); PG8_MMA(0, 1, At, B1); PG8_BAR; PG8_SCHED;
            PG8_LDA(At, 1, 1); PG8_STAGE(PG8_SB(1, 0), b3, voffB); PG8_STAGE(PG8_SB(1, 1), b3 + hstep, voffB); PG8_STAGE(PG8_SA(1, 0), a3, voffA);
            PG8_WAIT_V(8); PG8_WAIT_L(0); PG8_BAR; PG8_MMA(1, 0, At, B0); PG8_MMA(1, 1, At, B1); PG8_BAR; PG8_SCHED;
            } else {
            PG8_LDB(B0, 0, 0); PG8_SCHED; PG8_LDA(At, 0, 0); PG8_STAGE(PG8_SA(1, 1), a1 + hstep, voffA);
            PG8_WAIT_L(8); PG8_BAR; PG8_WAIT_L(0); PG8_MMA(0, 0, At, B0); PG8_BAR; PG8_SCHED;
            PG8_LDB(B1, 0, 1); PG8_STAGE(PG8_SB(0, 0), b2, voffB);
            PG8_BAR; PG8_WAIT_L(0); PG8_MMA(0, 1, At, B1); PG8_BAR;
            PG8_LDA(At, 0, 1); PG8_STAGE(PG8_SA(0, 0), a2, voffA);
            PG8_BAR; PG8_WAIT_L(0); PG8_MMA(1, 0, At, B0); PG8_BAR; PG8_SCHED;
            PG8_STAGE(PG8_SB(0, 1), b2 + hstep, voffB);
            PG8_WAIT_V(6); PG8_BAR; PG8_MMA(1, 1, At, B1); PG8_BAR;
            PG8_LDB(B0, 1, 0); PG8_SCHED; PG8_LDA(At, 1, 0); PG8_STAGE(PG8_SA(0, 1), a2 + hstep, voffA);
            PG8_WAIT_L(8); PG8_BAR; PG8_WAIT_L(0); PG8_MMA(0, 0, At, B0); PG8_BAR; PG8_SCHED;
            PG8_LDB(B1, 1, 1); PG8_STAGE(PG8_SB(1, 0), b3, voffB);
            PG8_BAR; PG8_WAIT_L(0); PG8_MMA(0, 1, At, B1); PG8_BAR;
            PG8_LDA(At, 1, 1); PG8_STAGE(PG8_SA(1, 0), a3, voffA);
            PG8_BAR; PG8_WAIT_L(0); PG8_MMA(1, 0, At, B0); PG8_BAR; PG8_SCHED;
            PG8_STAGE(PG8_SB(1, 1), b3 + hstep, voffB);
            PG8_WAIT_V(6); PG8_BAR; PG8_MMA(1, 1, At, B1); PG8_BAR;
            }
        }
        if constexpr (ALIGN_EPI) { if (wr == 0) PG8_BAR; }
        if constexpr (!Epi::AFTER_DRAIN) { E(acc, cur, wr, wc, fr, fq); S.done(cur); }
        if (!has_next) break;
#pragma unroll
        for (int a = 0; a < 2; ++a)
#pragma unroll
            for (int b = 0; b < 2; ++b)
#pragma unroll
                for (int m = 0; m < 4; ++m)
#pragma unroll
                    for (int n = 0; n < 2; ++n) acc[a][b][m][n] = (f32x4){0.f, 0.f, 0.f, 0.f};
        cur = nxt; cA = nA; cB = nB; ++ui;
        if constexpr (ALIGN_EPI) { if (wr == 1) PG8_BAR; }
    }
    PG8_WAIT_V(0);
    if constexpr (!ALIGN_EPI) { if (wr == 0) PG8_BAR; }
    PG8_BAR;
    if constexpr (Epi::AFTER_DRAIN) { E.fused(acc, cur, wr, wc, fr, fq, lds, wid, lane); S.done(cur); }
#undef PG8_SA
#undef PG8_SB
#undef PG8_STAGE
#undef PG8_LDA
#undef PG8_LDB
#undef PG8_MMA
#undef PG8_WAIT_V
#undef PG8_WAIT_L
#undef PG8_BAR
#undef PG8_SCHED
}
}

#ifndef PG8_SP2
#define PG8_SP2 true
#endif
#ifndef PG8_ALIGN
#define PG8_ALIGN true
#endif
#include <hip/hip_bf16.h>
#include <cmath>
#include <hip/hip_bf16.h>
#include <cmath>
namespace attn_body {
using bf16=__hip_bfloat16;
using bf16x8=__attribute__((ext_vector_type(8)))short;
using s16x4=__attribute__((ext_vector_type(4)))short;
using f32x16=__attribute__((ext_vector_type(16)))float;
using u32x4=__attribute__((ext_vector_type(4)))unsigned;
constexpr int BATCH=4,NHEAD=16,SEQ=4096,D=64,DM=NHEAD*D;
constexpr int NW=8,QBLK=32,QB=QBLK*NW,KVBLK=64,NQB=SEQ/QB;
constexpr int ATTN_PITCH=DM, ATTN_UNIT_ROWS=QB;
__device__ __forceinline__ int crow(int r,int hi){return (r&3)+8*(r>>2)+4*hi;}
#define SBAR() __builtin_amdgcn_sched_barrier(0)
__device__ __forceinline__ void cmask(f32x16&p0,f32x16&p1,int jb,int qrel,int hi){
  const float NEG=-INFINITY; int kb=64*jb+4*hi;
  #pragma unroll
  for(int r=0;r<16;++r){int kv=kb+(r&3)+8*(r>>2); if(kv>qrel)p0[r]=NEG; if(kv+32>qrel)p1[r]=NEG;}
}

constexpr int NSLOT=3, SLOTB=8192;
constexpr int VSLOTB=2*SLOTB;
constexpr int LDS_K=0, LDS_V=NSLOT*SLOTB, LDS_WS=LDS_V+NSLOT*VSLOTB, LDS_OST=LDS_WS+NW*64*4, LDS_Q=LDS_OST+NW*4096, LDS_BYTES=LDS_Q+NW*4096;
constexpr float C2=0.125f*1.4426950408889634f;
__device__ __forceinline__ void glds16(const void*gsrc,unsigned lds_dst){unsigned keep;
  asm volatile("s_mov_b32 %0, m0\n\ts_mov_b32 m0, %2\n\ts_nop 0\n\tglobal_load_lds_dwordx4 %1, off\n\ts_mov_b32 m0, %0":"=&s"(keep):"v"(gsrc),"s"(lds_dst):"memory");}
__device__ __forceinline__ float max3f(float a,float b,float c){float r;asm("v_max3_f32 %0, %1, %2, %3":"=v"(r):"v"(a),"v"(b),"v"(c));return r;}
__device__ __forceinline__ float max2f(float a,float b){float r;asm("v_max_f32_e32 %0, %1, %2":"=v"(r):"v"(a),"v"(b));return r;}
__device__ __forceinline__ float fadd_s(float a,float b){float r;asm("v_add_f32_e32 %0, %1, %2":"=v"(r):"v"(a),"v"(b));return r;}
__device__ __forceinline__ float fsub_s(float a,float b){float r;asm("v_sub_f32_e32 %0, %1, %2":"=v"(r):"v"(a),"v"(b));return r;}
typedef float f32x2_t __attribute__((ext_vector_type(2))); typedef __bf16 bf16x2_t __attribute__((ext_vector_type(2)));
__device__ __forceinline__ unsigned cvtpk_s(float lo,float hi){f32x2_t v={lo,hi};bf16x2_t b=__builtin_convertvector(v,bf16x2_t);return __builtin_bit_cast(unsigned,b);}
#define WAIT_BAR(N) asm volatile("s_waitcnt vmcnt(" #N ") lgkmcnt(0)\n\ts_barrier":::"memory")

__device__ __forceinline__ void qkt(f32x16&p0,f32x16&p1,const char*Kslot,const bf16x8*qr,const f32x16&negm,int r32,int hi){
  const char*kb=Kslot+hi*1024+r32*16;
  #pragma unroll
  for(int d0=0;d0<4;++d0){
    const bf16x8 b0=*reinterpret_cast<const bf16x8*>(kb+d0*2048);
    const bf16x8 b1=*reinterpret_cast<const bf16x8*>(kb+d0*2048+512);
    if(d0==0){p0=__builtin_amdgcn_mfma_f32_32x32x16_bf16(b0,qr[0],negm,0,0,0);p1=__builtin_amdgcn_mfma_f32_32x32x16_bf16(b1,qr[0],negm,0,0,0);}
    else{p0=__builtin_amdgcn_mfma_f32_32x32x16_bf16(b0,qr[d0],p0,0,0,0);p1=__builtin_amdgcn_mfma_f32_32x32x16_bf16(b1,qr[d0],p1,0,0,0);}}
}
typedef __attribute__((address_space(3))) const char* lds_cptr;
typedef short v4i16_t __attribute__((ext_vector_type(4)));
__device__ __forceinline__ void kload8(bf16x8*kf,lds_cptr kp){
  kf[0]=*(const __attribute__((address_space(3))) bf16x8*)(kp);      kf[1]=*(const __attribute__((address_space(3))) bf16x8*)(kp+512);
  kf[2]=*(const __attribute__((address_space(3))) bf16x8*)(kp+2048); kf[3]=*(const __attribute__((address_space(3))) bf16x8*)(kp+2560);
  kf[4]=*(const __attribute__((address_space(3))) bf16x8*)(kp+4096); kf[5]=*(const __attribute__((address_space(3))) bf16x8*)(kp+4608);
  kf[6]=*(const __attribute__((address_space(3))) bf16x8*)(kp+6144); kf[7]=*(const __attribute__((address_space(3))) bf16x8*)(kp+6656);
}
__device__ __forceinline__ void kload2(bf16x8*kf,lds_cptr kp,int j){ kf[2*j]=*(const __attribute__((address_space(3))) bf16x8*)(kp+j*2048); kf[2*j+1]=*(const __attribute__((address_space(3))) bf16x8*)(kp+j*2048+512); }
__device__ __forceinline__ s16x4 vtr(lds_cptr p){ return __builtin_bit_cast(s16x4,__builtin_amdgcn_ds_read_tr16_b64_v4i16((__attribute__((address_space(3))) v4i16_t*)p)); }
__device__ __forceinline__ float rowmax(const f32x16&p0,const f32x16&p1){
  float a=max3f(p0[0],p0[1],p1[0]),b=max3f(p0[2],p0[3],p1[1]);a=max3f(a,p1[2],p1[3]);
  #pragma unroll
  for(int r=4;r<16;r+=4){a=max3f(a,p0[r],p0[r+1]);b=max3f(b,p0[r+2],p0[r+3]);a=max3f(a,p1[r],p1[r+1]);b=max3f(b,p1[r+2],p1[r+3]);}
  const float m=max2f(a,b);
  auto rr=__builtin_amdgcn_permlane32_swap(__float_as_uint(m),__float_as_uint(m),false,false);
  return max2f(__uint_as_float(rr[0]),__uint_as_float(rr[1]));
}
__device__ __forceinline__ void pv(f32x16*o,int vb,bf16x8 pa0,bf16x8 pa1,bf16x8 pa2,bf16x8 pa3){
  #pragma unroll
  for(int d0=0;d0<4;++d0){s16x4 lo[4],hi[4];
    #pragma unroll
    for(int ks=0;ks<4;++ks){
      asm volatile("ds_read_b64_tr_b16 %0,%1 offset:%c2":"=&v"(lo[ks]):"v"(vb),"i"(d0*4096+ks*1024):"memory");
      asm volatile("ds_read_b64_tr_b16 %0,%1 offset:%c2":"=&v"(hi[ks]):"v"(vb),"i"(d0*4096+ks*1024+512):"memory");}
    asm volatile("s_waitcnt lgkmcnt(0)":::"memory");SBAR();
    #define PK(k) (bf16x8){lo[k][0],lo[k][1],lo[k][2],lo[k][3],hi[k][0],hi[k][1],hi[k][2],hi[k][3]}
    o[d0]=__builtin_amdgcn_mfma_f32_32x32x16_bf16(pa0,PK(0),o[d0],0,0,0);
    o[d0]=__builtin_amdgcn_mfma_f32_32x32x16_bf16(pa1,PK(1),o[d0],0,0,0);
    o[d0]=__builtin_amdgcn_mfma_f32_32x32x16_bf16(pa2,PK(2),o[d0],0,0,0);
    o[d0]=__builtin_amdgcn_mfma_f32_32x32x16_bf16(pa3,PK(3),o[d0],0,0,0);
    #undef PK
  }
}

#ifndef ATTN_STORE16
#define ATTN_STORE16(p,v) (*(u32x4*)(p)=(v))
#endif
template<int THRL> __device__ __forceinline__ void attn_unit(int b,int h,int vcol,int qb,int t0,float sl2,float mref,const bf16*Q,const bf16*K,const bf16*V,bf16*Ob,int opitch,char*shm,const int wave_s){
  const int tid=fresh_tid(wave_s),lane=tid&63,r32=lane&31,hi=lane>>5; const int wid=__builtin_amdgcn_readfirstlane(tid>>6);
  const long rowbase=(long)b*SEQ; const int q0=qb*QB;
  const bf16*Qw=Q+(rowbase+q0+wid*QBLK)*DM+h*D;
  const bf16*Kh=K+(rowbase+(long)t0*KVBLK)*DM+h*D,*Vh=V+(rowbase+(long)t0*KVBLK)*DM+vcol; const int q0e=q0-t0*KVBLK;
  const unsigned lds0=(unsigned)(uintptr_t)shm;
  float*wsf=(float*)(shm+LDS_WS)+wid*64;
  const bf16*ksrc=Kh+(long)lane*DM+wid*8;
  const bf16*vsrc=Vh+(long)(16*(wid&3)+(lane>>2))*DM+(wid>>2)*32+(lane&3)*8;
  const unsigned kdst=lds0+LDS_K+wid*1024, vdst=lds0+LDS_V+wid*1024;
  #define DMA_K(t,slot) glds16(ksrc+(long)(t)*KVBLK*DM,(unsigned)__builtin_amdgcn_readfirstlane(kdst+(slot)))
  #define DMA_V(t,slot) do{ glds16(vsrc+(long)(t)*KVBLK*DM,(unsigned)__builtin_amdgcn_readfirstlane(vdst+2*(slot))); glds16(vsrc+64+(long)(t)*KVBLK*DM,(unsigned)__builtin_amdgcn_readfirstlane(vdst+8192+2*(slot))); }while(0)
  const int vb0=(int)(lds0+LDS_V)+((lane>>4)&1)*32+(lane&3)*8+(4*hi+((lane&15)>>2))*64;
  const char*Kbase=shm+LDS_K; bf16x8 kf[8];
  const lds_cptr shm3=(lds_cptr)shm; const lds_cptr kp0=shm3+LDS_K+hi*1024+r32*16; const lds_cptr vp0=shm3+LDS_V+((lane>>4)&1)*32+(lane&3)*8+(4*hi+((lane&15)>>2))*64;
  const int NT=(q0+QB)/KVBLK-t0;
  DMA_K(0,0);DMA_V(0,0);DMA_K(1,SLOTB);
  bf16x8 qr[4];
  #pragma unroll
  for(int d0=0;d0<4;++d0)qr[d0]=*reinterpret_cast<const bf16x8*>(&Qw[(long)r32*DM+d0*16+hi*8]);
  const lds_cptr qp0=shm3+LDS_Q+wid*4096+lane*16;
  #pragma unroll
  for(int d0=0;d0<4;++d0)*(__attribute__((address_space(3))) bf16x8*)(const_cast<__attribute__((address_space(3))) char*>(qp0)+d0*1024)=qr[d0];
  #define QLD(d) (*(const __attribute__((address_space(3))) bf16x8*)(qp0+(d)*1024))
  float mhat=0.f,l_reg=0.f;f32x16 o[4];o[0]=f32x16{};o[1]=f32x16{};o[2]=f32x16{};o[3]=f32x16{};
  const int qrel=wid*QBLK+r32;
  #define CMASK(P0,P1,t) do{int jb_=(t)-(NT-4); if(jb_>=0)cmask(P0,P1,jb_,qrel,hi);}while(0)
  #define ALIBI(P0,P1,t) do{ const float b0_=fmaf(sl2,(float)(64*(t)-q0e+4*hi),-mhat), b1_=fmaf(sl2,32.f,b0_); \
    _Pragma("unroll") for(int r=0;r<16;++r){P0[r]=fmaf(sl2,(float)((r&3)+8*(r>>2)),P0[r]+b0_);P1[r]=fmaf(sl2,(float)((r&3)+8*(r>>2)),P1[r]+b1_);} }while(0)
  bool resc=false;
  #define START(P0,P1) do{ const float rm=rowmax(P0,P1); resc=false; \
    { const float dl=__builtin_fmaxf(rm,fmaf(sl2,(float)qrel,-mref)); mhat=fadd_s(mhat,dl);     \
      _Pragma("unroll") for(int r=0;r<16;++r){P0[r]=fsub_s(P0[r],dl);P1[r]=fsub_s(P1[r],dl);} \
      } \
    _Pragma("unroll") for(int r=0;r<16;++r)P0[r]=__builtin_amdgcn_exp2f(P0[r]); }while(0)
  #define RESC() do{ if(resc){ asm volatile("s_waitcnt lgkmcnt(0)":::"memory"); \
      _Pragma("unroll") for(int d_=0;d_<4;++d_) _Pragma("unroll") for(int r=0;r<16;++r)o[d_][r]*=wsf[crow(r,hi)]; } }while(0)
  f32x16 pA0,pA1,pB0,pB1;
  int sl_prev=0,sl_cur=0,sl_next=SLOTB;
  #define ROT() do{sl_prev=sl_cur;sl_cur=sl_next;sl_next=(sl_next==(NSLOT-1)*SLOTB)?0:sl_next+SLOTB;}while(0)
  DMA_K(2,2*SLOTB);
  WAIT_BAR(3);
  qkt(pA0,pA1,Kbase,qr,f32x16{},r32,hi);asm volatile("s_nop 15\n\ts_nop 7":"+v"(pA0),"+v"(pA1));ALIBI(pA0,pA1,0);CMASK(pA0,pA1,0);
  START(pA0,pA1);
  _Pragma("unroll") for(int r=0;r<16;++r)pA1[r]=__builtin_amdgcn_exp2f(pA1[r]);
  WAIT_BAR(0);
  DMA_K(3,0);DMA_V(1,SLOTB);
  ROT();
  kload8(kf,kp0+sl_cur);
  WAIT_BAR(3);
  s16x4 vlo[8],vhi[8]; u32x4 pw0,pw1,pw2,pw3;
  #define PKW(P,B) cvtpk_s(P[B],P[B+1])
  #define PAF(k) __builtin_bit_cast(bf16x8,pw##k)
  #define VFR(i) (bf16x8){vlo[i][0],vlo[i][1],vlo[i][2],vlo[i][3],vhi[i][0],vhi[i][1],vhi[i][2],vhi[i][3]}
  #define PIN(x) asm volatile("":"+v"(x))
  #define MX3(a,b,c) __builtin_fmaxf(__builtin_fmaxf((a),(b)),(c))
  #define GAPA(MF,A0,A1,A2,A3,W0,W1,PW) do{ MF; sacc+=A0; sacc+=A1; sacc+=A2; sacc+=A3; PIN(sacc); W0; W1; PIN(PW); SBAR(); }while(0)
  #define EX(v) __builtin_amdgcn_exp2f(v)
  #define GAPB(MF,X,B) do{ MF; X[B]=EX(X[B]); X[B+1]=EX(X[B+1]); X[B+2]=EX(X[B+2]); X[B+3]=EX(X[B+3]); PIN(X); SBAR(); }while(0)
  #define GAPB2(MF,X,B) do{ MF; X[B]=EX(X[B]); X[B+1]=EX(X[B+1]); PIN(X); SBAR(); }while(0)
  #define VRD2(i) do{ vlo[i]=vtr(vp_+((((i)+8)>>2)*4096+((i)&3)*1024)); vhi[i]=vtr(vp_+((((i)+8)>>2)*4096+((i)&3)*1024+512)); SBAR(); }while(0)
  #define VRD(i) do{ vlo[i]=vtr(vp_+(((i)>>2)*4096+((i)&3)*1024)); vhi[i]=vtr(vp_+(((i)>>2)*4096+((i)&3)*1024+512)); }while(0)
  #define KRD(G,j) do{ if(G){ kload2(kf,kp0+sl_next,j); SBAR(); } }while(0)
  #define STEP(C0,C1,P0,P1,t,GK,GV,GL) do{ SBAR(); \
    const lds_cptr vp_=vp0+2*sl_prev; \
    bf16x8 qa_=QLD(0), qb_=QLD(1); VRD(0); SBAR(); float sacc=(P0[0]+P0[1]); \
    GAPA(C0=__builtin_amdgcn_mfma_f32_32x32x16_bf16(kf[0],qa_,f32x16{},0,0,0), P0[2],P0[3],P0[4],P0[5],     pw0[0]=PKW(P0,0), pw0[1]=PKW(P0,2), pw0); \
    VRD(4); SBAR(); GAPA(C1=__builtin_amdgcn_mfma_f32_32x32x16_bf16(kf[1],qa_,f32x16{},0,0,0), P0[6],P0[7],P0[8],P0[9],     pw0[2]=PKW(P0,4), pw0[3]=PKW(P0,6), pw0); \
    qa_=QLD(2); VRD(1); SBAR(); GAPA(C0=__builtin_amdgcn_mfma_f32_32x32x16_bf16(kf[2],qb_,C0,0,0,0),   P0[10],P0[11],P0[12],P0[13], pw1[0]=PKW(P0,8), pw1[1]=PKW(P0,10), pw1); \
    VRD(5); SBAR(); GAPA(C1=__builtin_amdgcn_mfma_f32_32x32x16_bf16(kf[3],qb_,C1,0,0,0),   P0[14],P0[15],P1[0],P1[1],   pw1[2]=PKW(P0,12),pw1[3]=PKW(P0,14), pw1); \
    qb_=QLD(3); VRD(2); SBAR(); GAPA(C0=__builtin_amdgcn_mfma_f32_32x32x16_bf16(kf[4],qa_,C0,0,0,0),   P1[2],P1[3],P1[4],P1[5],     pw2[0]=PKW(P1,0), pw2[1]=PKW(P1,2), pw2); \
    VRD(6); SBAR(); GAPA(C1=__builtin_amdgcn_mfma_f32_32x32x16_bf16(kf[5],qa_,C1,0,0,0),   P1[6],P1[7],P1[8],P1[9],     pw2[2]=PKW(P1,4), pw2[3]=PKW(P1,6), pw2); \
    VRD(3); SBAR(); GAPA(C0=__builtin_amdgcn_mfma_f32_32x32x16_bf16(kf[6],qb_,C0,0,0,0),   P1[10],P1[11],P1[12],P1[13], pw3[0]=PKW(P1,8), pw3[1]=PKW(P1,10), pw3); \
    VRD(7); SBAR(); GAPA(C1=__builtin_amdgcn_mfma_f32_32x32x16_bf16(kf[7],qb_,C1,0,0,0),   P1[14],P1[15],0.f,0.f,       pw3[2]=PKW(P1,12),pw3[3]=PKW(P1,14), pw3); \
    l_reg+=sacc; \
    if(GK){DMA_K((t)+3,sl_cur);} if(GV){DMA_V((t)+1,sl_next);} \
    ALIBI(C0,C1,t); CMASK(C0,C1,t); \
    { float a=MX3(C0[0],C0[1],C1[0]),b=MX3(C0[2],C0[3],C1[1]); a=MX3(a,C1[2],C1[3]); \
      _Pragma("unroll") for(int r=4;r<16;r+=4){a=MX3(a,C0[r],C0[r+1]);b=MX3(b,C0[r+2],C0[r+3]);a=MX3(a,C1[r],C1[r+1]);b=MX3(b,C1[r+2],C1[r+3]);} \
      float rm=__builtin_fmaxf(a,b); { auto rr=__builtin_amdgcn_permlane32_swap(__float_as_uint(rm),__float_as_uint(rm),false,false); rm=__builtin_fmaxf(__uint_as_float(rr[0]),__uint_as_float(rr[1])); } \
      resc=false; \
      if(__builtin_expect(__any(rm>(float)THRL),0)){ const float dl=__builtin_fmaxf(rm,0.f); mhat+=dl; \
        _Pragma("unroll") for(int r=0;r<16;++r){C0[r]-=dl;C1[r]-=dl;} \
        const float f=__builtin_amdgcn_exp2f(-dl); l_reg*=f; if(hi==0)wsf[r32]=f; resc=true; } } \
    SBAR(); \
    GAPB2(o[0]=__builtin_amdgcn_mfma_f32_32x32x16_bf16(PAF(0),VFR(0),o[0],0,0,0), C0,0); VRD2(0); \
    GAPB2(o[1]=__builtin_amdgcn_mfma_f32_32x32x16_bf16(PAF(0),VFR(4),o[1],0,0,0), C0,2); VRD2(4); \
    KRD(GL,0); GAPB2(o[0]=__builtin_amdgcn_mfma_f32_32x32x16_bf16(PAF(1),VFR(1),o[0],0,0,0), C0,4); VRD2(1); \
    KRD(GL,1); GAPB2(o[1]=__builtin_amdgcn_mfma_f32_32x32x16_bf16(PAF(1),VFR(5),o[1],0,0,0), C0,6); VRD2(5); \
    KRD(GL,2); GAPB2(o[0]=__builtin_amdgcn_mfma_f32_32x32x16_bf16(PAF(2),VFR(2),o[0],0,0,0), C0,8); VRD2(2); \
    KRD(GL,3); GAPB2(o[1]=__builtin_amdgcn_mfma_f32_32x32x16_bf16(PAF(2),VFR(6),o[1],0,0,0), C0,10); VRD2(6); \
    GAPB2(o[0]=__builtin_amdgcn_mfma_f32_32x32x16_bf16(PAF(3),VFR(3),o[0],0,0,0), C0,12); VRD2(3); \
    GAPB2(o[1]=__builtin_amdgcn_mfma_f32_32x32x16_bf16(PAF(3),VFR(7),o[1],0,0,0), C0,14); VRD2(7); \
    GAPB2(o[2]=__builtin_amdgcn_mfma_f32_32x32x16_bf16(PAF(0),VFR(0),o[2],0,0,0), C1,0); \
    GAPB2(o[3]=__builtin_amdgcn_mfma_f32_32x32x16_bf16(PAF(0),VFR(4),o[3],0,0,0), C1,2); \
    GAPB2(o[2]=__builtin_amdgcn_mfma_f32_32x32x16_bf16(PAF(1),VFR(1),o[2],0,0,0), C1,4); \
    GAPB2(o[3]=__builtin_amdgcn_mfma_f32_32x32x16_bf16(PAF(1),VFR(5),o[3],0,0,0), C1,6); \
    GAPB2(o[2]=__builtin_amdgcn_mfma_f32_32x32x16_bf16(PAF(2),VFR(2),o[2],0,0,0), C1,8); \
    GAPB2(o[3]=__builtin_amdgcn_mfma_f32_32x32x16_bf16(PAF(2),VFR(6),o[3],0,0,0), C1,10); \
    GAPB2(o[2]=__builtin_amdgcn_mfma_f32_32x32x16_bf16(PAF(3),VFR(3),o[2],0,0,0), C1,12); \
    GAPB2(o[3]=__builtin_amdgcn_mfma_f32_32x32x16_bf16(PAF(3),VFR(7),o[3],0,0,0), C1,14); \
    }while(0)
  int t=1;
  #undef CMASK
  #define CMASK(P0,P1,t) do{}while(0)
  for(;t+5<NT;t+=2){
    STEP(pB0,pB1,pA0,pA1,t,true,true,true);     WAIT_BAR(3); RESC(); ROT();
    STEP(pA0,pA1,pB0,pB1,t+1,true,true,true);   WAIT_BAR(3); RESC(); ROT();
  }
  #undef CMASK
  #define CMASK(P0,P1,t) do{int jb_=(t)-(NT-4); if(jb_>=0)cmask(P0,P1,jb_,qrel,hi);}while(0)
  #define ENDW(tt) do{ if((tt)+3<NT){WAIT_BAR(3);} else if((tt)+2<NT){WAIT_BAR(2);} else {WAIT_BAR(0);} }while(0)
  for(;t+1<NT;t+=2){
    STEP(pB0,pB1,pA0,pA1,t,(t+3<NT),(t+1<NT),(t+1<NT));       ENDW(t);   RESC(); ROT();
    STEP(pA0,pA1,pB0,pB1,t+1,(t+4<NT),(t+2<NT),(t+2<NT));     ENDW(t+1); RESC(); ROT();
  }
  STEP(pB0,pB1,pA0,pA1,NT-1,false,false,false); RESC();
  { float sacc=pB0[0]+pB0[1]; _Pragma("unroll") for(int r=2;r<16;++r)sacc+=pB0[r]; _Pragma("unroll") for(int r=0;r<16;++r)sacc+=pB1[r]; l_reg+=sacc;
    pw0=(u32x4){PKW(pB0,0),PKW(pB0,2),PKW(pB0,4),PKW(pB0,6)};pw1=(u32x4){PKW(pB0,8),PKW(pB0,10),PKW(pB0,12),PKW(pB0,14)};pw2=(u32x4){PKW(pB1,0),PKW(pB1,2),PKW(pB1,4),PKW(pB1,6)};pw3=(u32x4){PKW(pB1,8),PKW(pB1,10),PKW(pB1,12),PKW(pB1,14)};
    SBAR(); pv(o,vb0+2*sl_cur,PAF(0),PAF(1),PAF(2),PAF(3)); }
  #undef PKW
  #undef PAF
  #undef VFR
  #undef PIN
  #undef MX3
  #undef GAPA
  #undef GAPB
  #undef GAPB2
  #undef VRD2
  #undef EX
  #undef VRD
  #undef KRD
  #undef STEP
  #undef ENDW
  {auto rr=__builtin_amdgcn_permlane32_swap(__float_as_uint(l_reg),__float_as_uint(l_reg),false,false);l_reg=__uint_as_float(rr[0])+__uint_as_float(rr[1]);}
  if(hi==0)wsf[32+r32]=l_reg;asm volatile("s_waitcnt lgkmcnt(0)":::"memory");
  float rli[16];
  #pragma unroll
  for(int r=0;r<16;++r)rli[r]=__builtin_amdgcn_rcpf(wsf[32+crow(r,hi)]);
  bf16*Ow=Ob+(long)(wid*QBLK)*opitch;
  { bf16*stg=(bf16*)(shm+LDS_OST)+wid*2048;
    #pragma unroll
    for(int hf=0;hf<2;++hf){
      #pragma unroll
      for(int r=0;r<16;++r){const int orow=crow(r,hi);
        #pragma unroll
        for(int d0=0;d0<2;++d0)stg[orow*64+d0*32+r32]=__float2bfloat16(o[2*hf+d0][r]*rli[r]);}
      asm volatile("s_waitcnt lgkmcnt(0)":::"memory");
      #pragma unroll
      for(int i=0;i<4;++i){const int row=i*8+(lane>>3),ch=lane&7; const u32x4 v=*(const u32x4*)(stg+row*64+ch*8); ATTN_STORE16(Ow+(long)row*opitch+hf*64+ch*8,v);}
      asm volatile("s_waitcnt lgkmcnt(0)":::"memory"); } }
  asm volatile("s_waitcnt lgkmcnt(0)\n\ts_barrier":::"memory");
  #undef DMA_K
  #undef DMA_V
  #undef QLD
  #undef CMASK
  #undef ALIBI
  #undef START
  #undef RESC
  #undef ROT
}
constexpr int ATTN_LDS_BYTES=LDS_BYTES;
#undef SBAR
#undef WAIT_BAR
}
constexpr int NWAVES = 8, NTHR = 512;
constexpr int BATCH = 4, SEQ = 4096, TT = BATCH * SEQ, DMOD = 1024, FF = 4096, DIN = 8200;
constexpr float EPSN = 1e-6f;
constexpr size_t MiB = 1u << 20;
constexpr size_t WS_WIN = 0, WS_W1T = 0, WS_W2T = 8 * MiB;
constexpr size_t WS_XN = 16 * MiB;
constexpr size_t WS_B0 = 48 * MiB, WS_BSTR = 32 * MiB;
constexpr size_t WS_H = 48 * MiB;
constexpr size_t WS_WAT = 240 * MiB, WS_WMT = 242 * MiB, WS_WOT = 244 * MiB, WS_IF = 246 * MiB, WS_CTL = 247 * MiB, WS_END = 248 * MiB;
constexpr size_t CTL_BYTES = 256 * 1024;
constexpr int RING_BYTES = 131072, LDS_BYTES = 147456, MISC_OFF = LDS_BYTES - 256;

#define LAS __attribute__((address_space(3)))
typedef unsigned short bf16;
typedef unsigned v4u __attribute__((ext_vector_type(4)));
typedef unsigned v2u __attribute__((ext_vector_type(2)));
typedef float f32x4 __attribute__((ext_vector_type(4)));
typedef float f32x16 __attribute__((ext_vector_type(16)));
typedef short bf16x8 __attribute__((ext_vector_type(8)));
typedef short s16x4 __attribute__((ext_vector_type(4)));
__device__ __forceinline__ unsigned f2bf(float f) { unsigned u = __builtin_bit_cast(unsigned, f); return (u + 0x7fffu + ((u >> 16) & 1u)) >> 16; }
__device__ __forceinline__ unsigned pk2(float lo, float hi) { return f2bf(lo) | (f2bf(hi) << 16); }
__device__ __forceinline__ unsigned cvtpk(float lo, float hi) { return pg8::cvt_pk_bf16(lo, hi); }
__device__ __forceinline__ float bflo(unsigned w) { return __uint_as_float(w << 16); }
__device__ __forceinline__ float bfhi(unsigned w) { return __uint_as_float(w & 0xffff0000u); }
__device__ __forceinline__ float wave_sum(float v) {
#pragma unroll
    for (int o = 1; o < 64; o <<= 1) v += sx(v, o);
    return v;
}
__device__ __forceinline__ void transpose_item(const float* W, int ldw, int K, bf16* WT, int nd0, int ns0, int k0, const float* kscale, LAS float* scr, int lane) {
    float tv[32];
#pragma unroll
    for (int i = 0; i < 32; ++i) { const int kk = 2 * i + (lane >> 5); tv[i] = __builtin_nontemporal_load(W + (size_t)(k0 + kk) * ldw + ns0 + (lane & 31)); }
#pragma unroll
    for (int i = 0; i < 32; ++i) { const int kk = 2 * i + (lane >> 5); float v = tv[i]; if (kscale) v *= kscale[k0 + kk]; scr[kk * 33 + (lane & 31)] = v; }
    asm volatile("s_waitcnt lgkmcnt(0)" ::: "memory");
    const int c = lane & 7;
#pragma unroll
    for (int j = 0; j < 4; ++j) { const int n = (lane >> 3) + 8 * j; const LAS float* s = scr + (8 * c) * 33 + n;
        v4u o; o.x = pk2(s[0 * 33], s[1 * 33]); o.y = pk2(s[2 * 33], s[3 * 33]); o.z = pk2(s[4 * 33], s[5 * 33]); o.w = pk2(s[6 * 33], s[7 * 33]);
        *(v4u*)(WT + (size_t)(nd0 + n) * K + k0 + 8 * c) = o; }
    asm volatile("s_waitcnt lgkmcnt(0)" ::: "memory");
}

namespace mls {
constexpr int OFF_QS = 0, OFF_KS = 17408, OFF_KTS = 34816, OFF_VTS = 53248, OFF_PS = 90112, OFF_CS = 99328, OFF_RS = 99584, OFF_QN = 100096, OFF_NV = 100352, OFF_HSQ = 100864, OFF_NG = 102912;
constexpr int QPB = 272, SPB = 144;
#define MFMA32(a, b, c) __builtin_amdgcn_mfma_f32_32x32x16_bf16((a), (b), (c), 0, 0, 0)
__device__ __forceinline__ bf16x8 ld128(LAS const unsigned char* p) { return *(LAS const bf16x8*)p; }
__device__ __forceinline__ float bfe(const v4u& u, int i) { const unsigned w = (i >> 1) == 0 ? u.x : (i >> 1) == 1 ? u.y : (i >> 1) == 2 ? u.z : u.w; return (i & 1) ? bfhi(w) : bflo(w); }

__device__ __forceinline__ float shf(float v, int src) { return __builtin_bit_cast(float, __builtin_amdgcn_ds_bpermute(src << 2, __builtin_bit_cast(int, v))); }
constexpr int OFF_MC = 103936, OFF_M63 = 104192, OFF_G = 104448, OFF_CM = 104704;
#define CH_FRESH() int tid = tid0; asm volatile("" : "+v"(tid)); const int lane = tid & 63, r32 = lane & 31, hi = lane >> 5; (void)r32; (void)hi
constexpr int NSEG = 8, CPS = 64 / NSEG;
constexpr size_t ST_FLOATS = 128 * 256 + 128 + 64;
static_assert(MiB + 16 * (NSEG - 1) * ST_FLOATS * 4 <= 16 * MiB, "chain state scratch must fit the upper half of B3");
template <bool FULL>
__device__ __forceinline__ void chain_run(LAS unsigned char* L, const int tid0, const int wid, const int h, const size_t row0, const int c0, const bf16* QKc, bf16* MV, const bf16* MLO, const f32x4* GS, f32x16 (&acc)[4]) {
    LAS float* CS = (LAS float*)(L + OFF_CS); LAS float* RS = (LAS float*)(L + OFF_RS); LAS float* QN = (LAS float*)(L + OFF_QN);
    LAS float* NV = (LAS float*)(L + OFF_NV); LAS float* HSQ = (LAS float*)(L + OFF_HSQ); LAS float* NG = (LAS float*)(L + OFF_NG);
    LAS float* MC = (LAS float*)(L + OFF_MC); LAS float* M63A = (LAS float*)(L + OFF_M63);
    const bool isK = wid < 4;
    v4u pq[4], pv[4]; f32x4 gsv;
#define CH_PREFETCH(ci) do { CH_FRESH(); int c_ = (ci); asm volatile("" : "+s"(c_)); const size_t rb_ = row0 + (size_t)(c0 + c_) * 64; \
        const char* qb_ = (const char*)QKc + rb_ * 2048; const char* vb_ = (const char*)MV + rb_ * 2048; \
        if (isK) { const unsigned koff = (unsigned)(((4 * ((tid >> 4) & 15)) * 1024 + 512 + h * 128 + 8 * (tid & 15)) * 2); \
            _Pragma("unroll") for (int j = 0; j < 4; ++j) pq[j] = *(const v4u*)(qb_ + koff + j * 2048); } \
        else if (FULL) { const unsigned koff = (unsigned)(((((tid - 256) >> 2)) * 1024 + h * 128 + 32 * ((tid - 256) & 3)) * 2); \
            _Pragma("unroll") for (int j = 0; j < 4; ++j) pq[j] = *(const v4u*)(qb_ + koff + j * 16); } \
        { const unsigned voff = (unsigned)(((4 * (tid >> 5)) * 1024 + h * 256 + 8 * (tid & 31)) * 2); \
            _Pragma("unroll") for (int j = 0; j < 4; ++j) pv[j] = *(const v4u*)(vb_ + voff + j * 2048); } \
        gsv = GS[c_ * 64 + lane]; } while (0)
    CH_PREFETCH(0);
#pragma unroll 1
    for (int c = 0; c < CPS; ++c) {
        int cq = c; asm volatile("" : "+s"(cq)); const size_t rb = row0 + (size_t)(c0 + cq) * 64;
        float Mt, wint, flr, decay;
        {
            CH_FRESH();
            const float mc = MC[cq], m63 = M63A[cq];
            const float bb = gsv[0], cc = gsv[1], cm = gsv[2];
            Mt = fmaxf(mc, cm);
            wint = __expf(mc - Mt);
            flr = __expf(-(bb + Mt));
            const float wsc = __expf(cc - m63);
            decay = __expf(mc - m63);
            if (FULL && wid == 0) CS[lane] = cc;
            if (isK) {
                const int kcg = tid & 15, ktg = (tid >> 4) & 15;
                float w4[4];
#pragma unroll
                for (int j = 0; j < 4; ++j) { w4[j] = shf(wsc, 4 * ktg + j); if (FULL) *(LAS v4u*)(L + OFF_KS + (4 * ktg + j) * QPB + kcg * 16) = pq[j]; }
#pragma unroll
                for (int i = 0; i < 8; ++i) { v2u o; o.x = cvtpk(bfe(pq[0], i) * w4[0], bfe(pq[1], i) * w4[1]); o.y = cvtpk(bfe(pq[2], i) * w4[2], bfe(pq[3], i) * w4[3]);
                    *(LAS v2u*)(L + OFF_KTS + (8 * kcg + i) * SPB + ktg * 8) = o; }
            } else if (FULL) {
                const int qt = (tid - 256) >> 2, qdg = (tid - 256) & 3;
#pragma unroll
                for (int j = 0; j < 4; ++j) *(LAS v4u*)(L + OFF_QS + qt * QPB + (32 * qdg + 8 * j) * 2) = pq[j];
            }
            const int vdg = tid & 31, vsg = tid >> 5;
#pragma unroll
            for (int i = 0; i < 8; ++i) { v2u o;
                const unsigned a0 = (i >> 1) == 0 ? pv[0].x : (i >> 1) == 1 ? pv[0].y : (i >> 1) == 2 ? pv[0].z : pv[0].w;
                const unsigned a1 = (i >> 1) == 0 ? pv[1].x : (i >> 1) == 1 ? pv[1].y : (i >> 1) == 2 ? pv[1].z : pv[1].w;
                const unsigned a2 = (i >> 1) == 0 ? pv[2].x : (i >> 1) == 1 ? pv[2].y : (i >> 1) == 2 ? pv[2].z : pv[2].w;
                const unsigned a3 = (i >> 1) == 0 ? pv[3].x : (i >> 1) == 1 ? pv[3].y : (i >> 1) == 2 ? pv[3].z : pv[3].w;
                if (i & 1) { o.x = (a0 >> 16) | (a1 & 0xffff0000u); o.y = (a2 >> 16) | (a3 & 0xffff0000u); }
                else       { o.x = (a0 & 0xffffu) | (a1 << 16);     o.y = (a2 & 0xffffu) | (a3 << 16); }
                *(LAS v2u*)(L + OFF_VTS + (8 * vdg + i) * SPB + vsg * 8) = o; }
        }
        __syncthreads();
        if (c + 1 < CPS) CH_PREFETCH(c + 1);
        v2u op[2][4];
        f32x16 nT[2];
        if (FULL) {
            {   CH_FRESH();
                const unsigned ooff = (unsigned)((r32 * 1024 + h * 256 + 32 * wid + 4 * hi) * 2);
#pragma unroll
                for (int tt = 0; tt < 2; ++tt)
#pragma unroll
                    for (int j = 0; j < 4; ++j) op[tt][j] = *(const v2u*)((const char*)MLO + (rb * 2048 + tt * 65536) + ooff + j * 16);
            }
            nT[0] = f32x16{}; nT[1] = f32x16{};
            {
                CH_FRESH();
                if (wid < 4) {
                    const int st = wid & 1, tt = wid >> 1, t = 32 * tt + r32;
                    if (st == 1 && tt == 0) {
#pragma unroll
                        for (int j = 0; j < 4; ++j) *(LAS v2u*)(L + OFF_PS + t * SPB + (32 + 8 * j + 4 * hi) * 2) = (v2u){0u, 0u};
                        if (hi == 0) RS[64 + t] = 0.f;
                    } else {
                        f32x16 sT = f32x16{};
                        LAS const unsigned char* kp = L + OFF_KS + (32 * st + r32) * QPB + 16 * hi; LAS const unsigned char* qp = L + OFF_QS + t * QPB + 16 * hi;
#pragma unroll
                        for (int half = 0; half < 2; ++half) { bf16x8 ka[4], qa[4];
#pragma unroll
                            for (int kk = 0; kk < 4; ++kk) { ka[kk] = ld128(kp + (4 * half + kk) * 32); qa[kk] = ld128(qp + (4 * half + kk) * 32); }
#pragma unroll
                            for (int kk = 0; kk < 4; ++kk) sT = MFMA32(ka[kk], qa[kk], sT); }
                        const float Mtl = shf(Mt, t);
                        float sum = 0.f;
#pragma unroll
                        for (int j = 0; j < 4; ++j) { const int s0 = 32 * st + 8 * j + 4 * hi; const f32x4 c4 = *(LAS const f32x4*)(CS + s0); float v[4];
#pragma unroll
                            for (int i = 0; i < 4; ++i) { const float e = __expf(fminf(c4[i] - Mtl, 0.f)); v[i] = (s0 + i <= t) ? sT[4 * j + i] * e : 0.f; sum += v[i]; }
                            v2u o; o.x = cvtpk(v[0], v[1]); o.y = cvtpk(v[2], v[3]); *(LAS v2u*)(L + OFF_PS + t * SPB + s0 * 2) = o; }
                        sum += shf(sum, lane ^ 32);
                        if (hi == 0) RS[64 * st + t] = sum;
                    }
                }
#pragma unroll
                for (int Td = 0; Td < 4; ++Td) {
                    v2u qv[2][2][2];
#pragma unroll
                    for (int jj = 0; jj < 2; ++jj)
#pragma unroll
                        for (int tt = 0; tt < 2; ++tt) { LAS const unsigned char* qp = L + OFF_QS + (32 * tt + r32) * QPB + (32 * Td + 16 * jj + 4 * hi) * 2;
                            qv[jj][tt][0] = *(LAS const v2u*)qp; qv[jj][tt][1] = *(LAS const v2u*)(qp + 16); }
#pragma unroll
                    for (int jj = 0; jj < 2; ++jj) {
                        v4u aw; aw.x = cvtpk(acc[Td][8 * jj + 0], acc[Td][8 * jj + 1]); aw.y = cvtpk(acc[Td][8 * jj + 2], acc[Td][8 * jj + 3]); aw.z = cvtpk(acc[Td][8 * jj + 4], acc[Td][8 * jj + 5]); aw.w = cvtpk(acc[Td][8 * jj + 6], acc[Td][8 * jj + 7]);
                        const bf16x8 af = __builtin_bit_cast(bf16x8, aw);
#pragma unroll
                        for (int tt = 0; tt < 2; ++tt) { const v4u qw = {qv[jj][tt][0].x, qv[jj][tt][0].y, qv[jj][tt][1].x, qv[jj][tt][1].y};
                            nT[tt] = MFMA32(af, __builtin_bit_cast(bf16x8, qw), nT[tt]); }
                    }
                }
                { const int t = 8 * wid + (lane >> 3), dp = lane & 7; LAS const unsigned char* qp = L + OFF_QS + t * QPB + dp * 32;
                    const v4u qa = *(LAS const v4u*)qp, qb = *(LAS const v4u*)(qp + 16); float d = 0.f;
#pragma unroll
                    for (int i = 0; i < 4; ++i) { const f32x4 n4 = *(LAS const f32x4*)(NV + 16 * dp + 4 * i); const v4u& q = (i < 2) ? qa : qb; const unsigned w0 = (i & 1) ? q.z : q.x, w1 = (i & 1) ? q.w : q.y;
                        d += bflo(w0) * n4[0] + bfhi(w0) * n4[1] + bflo(w1) * n4[2] + bfhi(w1) * n4[3]; }
                    d += shf(d, lane ^ 1); d += shf(d, lane ^ 2); d += shf(d, lane ^ 4);
                    if (dp == 0) QN[t] = d; }
            }
            __syncthreads();
        }
        {
            CH_FRESH();
            bf16x8 vf[4], pb[2][4], ka[4];
#pragma unroll
            for (int kk = 0; kk < 4; ++kk) vf[kk] = ld128(L + OFF_VTS + (32 * wid + r32) * SPB + (16 * kk + 8 * hi) * 2);
            if (FULL) {
#pragma unroll
                for (int tt = 0; tt < 2; ++tt)
#pragma unroll
                    for (int kk = 0; kk < 4; ++kk) if (tt == 1 || kk < 2) pb[tt][kk] = ld128(L + OFF_PS + (32 * tt + r32) * SPB + (16 * kk + 8 * hi) * 2);
            }
#pragma unroll
            for (int kk = 0; kk < 4; ++kk) ka[kk] = ld128(L + OFF_KTS + r32 * SPB + (16 * kk + 8 * hi) * 2);
            float dn[2];
            if (FULL) {
#pragma unroll
                for (int tt = 0; tt < 2; ++tt) { const int t = 32 * tt + r32; const float wl = shf(wint, t), fl = shf(flr, t);
                    const float den = wl * QN[t] + RS[t] + RS[64 + t]; dn[tt] = 1.f / fmaxf(fabsf(den), fl);
#pragma unroll
                    for (int r = 0; r < 16; ++r) nT[tt][r] *= wl; }
#pragma unroll
                for (int tt = 0; tt < 2; ++tt)
#pragma unroll
                    for (int kk = 0; kk < 4; ++kk) if (tt == 1 || kk < 2) nT[tt] = MFMA32(vf[kk], pb[tt][kk], nT[tt]);
            }
#pragma unroll
            for (int Td = 0; Td < 4; ++Td) {
#pragma unroll
                for (int r = 0; r < 16; ++r) acc[Td][r] *= decay;
#pragma unroll
                for (int kk = 0; kk < 4; ++kk) acc[Td] = MFMA32(ka[kk], vf[kk], acc[Td]);
                if (Td < 3) {
#pragma unroll
                    for (int kk = 0; kk < 4; ++kk) ka[kk] = ld128(L + OFF_KTS + (32 * (Td + 1) + r32) * SPB + (16 * kk + 8 * hi) * 2);
                }
            }
            if (FULL) {
#pragma unroll
                for (int tt = 0; tt < 2; ++tt) { const int t = 32 * tt + r32; float hs = 0.f;
#pragma unroll
                    for (int r = 0; r < 16; ++r) { nT[tt][r] *= dn[tt]; hs += nT[tt][r] * nT[tt][r]; }
                    hs += shf(hs, lane ^ 32);
                    if (hi == 0) HSQ[wid * 64 + t] = hs; }
            }
            if (tid < 128) { float s = 0.f;
#pragma unroll
                for (int i = 0; i < 8; ++i) { const v4u k8 = *(LAS const v4u*)(L + OFF_KTS + tid * SPB + i * 16); s += (bflo(k8.x) + bfhi(k8.x)) + (bflo(k8.y) + bfhi(k8.y)) + (bflo(k8.z) + bfhi(k8.z)) + (bflo(k8.w) + bfhi(k8.w)); }
                NV[tid] = decay * NV[tid] + s; }
        }
        __syncthreads();
        if (FULL) {
            CH_FRESH();
            const unsigned ooff = (unsigned)((r32 * 1024 + h * 256 + 32 * wid + 4 * hi) * 2);
#pragma unroll
            for (int tt = 0; tt < 2; ++tt) { const int t = 32 * tt + r32; float hsum = 0.f;
#pragma unroll
                for (int w = 0; w < 8; ++w) hsum += HSQ[w * 64 + t];
                const float rstd = __builtin_amdgcn_rsqf(hsum * (1.f / 256.f) + EPSN);
#pragma unroll
                for (int j = 0; j < 4; ++j) { const v2u ow = op[tt][j];
                    const float y0 = nT[tt][4 * j + 0] * rstd * bflo(ow.x), y1 = nT[tt][4 * j + 1] * rstd * bfhi(ow.x);
                    const float y2 = nT[tt][4 * j + 2] * rstd * bflo(ow.y), y3 = nT[tt][4 * j + 3] * rstd * bfhi(ow.y);
                    v2u o; o.x = cvtpk(y0, y1); o.y = cvtpk(y2, y3);
                    *(v2u*)((char*)MV + (rb * 2048 + tt * 65536) + ooff + j * 16) = o; } }
        }
    }
    __syncthreads();
#undef CH_PREFETCH
}

__device__ __forceinline__ void chain(LAS unsigned char* L, int b, int h, int seg, const bf16* QKc, bf16* MV, const bf16* MLO, const float* IFg, const float* ng, f32x4* GSall, float* STbh, unsigned* flags, const int wid) {
    const int tid0 = fresh_tid(wid);
    const size_t row0 = (size_t)b * SEQ; const int c0 = seg * CPS;
    LAS float* NV = (LAS float*)(L + OFF_NV); LAS float* NG = (LAS float*)(L + OFF_NG);
    LAS float* MC = (LAS float*)(L + OFF_MC); LAS float* M63A = (LAS float*)(L + OFF_M63); LAS float* GG = (LAS float*)(L + OFF_G); LAS float* CM63 = (LAS float*)(L + OFF_CM);
    f32x4* GS = GSall + (size_t)c0 * 64;
    if (tid0 < 128) NV[tid0] = 0.f;
    if (tid0 < 256) NG[tid0] = ng[h * 256 + tid0];
    {
        CH_FRESH();
        const int c = wid;
        const size_t tok = row0 + (size_t)(c0 + c) * 64 + lane;
        const float gi = IFg[tok * 8 + h], gf = IFg[tok * 8 + 4 + h];
        const float lf = fminf(gf, 0.f) - log1pf(__expf(-fabsf(gf)));
        float bb = lf;
#pragma unroll
        for (int o = 1; o < 64; o <<= 1) { const float v = shf(bb, lane - o); if (lane >= o) bb += v; }
        const float cc = gi - bb;
        float cm = cc;
#pragma unroll
        for (int o = 1; o < 64; o <<= 1) { const float v = shf(cm, lane - o); if (lane >= o) cm = fmaxf(cm, v); }
        GS[c * 64 + lane] = (f32x4){bb, cc, cm, 0.f};
        if (lane == 63) { GG[c] = bb; CM63[c] = cm; }
        asm volatile("s_waitcnt vmcnt(0)" ::: "memory");
        __syncthreads();
    }
    f32x16 acc[4];
#pragma unroll
    for (int i = 0; i < 4; ++i) acc[i] = f32x16{};
    float* STme = STbh + (size_t)seg * ST_FLOATS;
    if (seg < NSEG - 1) {
        { CH_FRESH(); if (tid == 0) { float m = 0.f, gs = 0.f;
            for (int c = 0; c < CPS; ++c) { MC[c] = m; const float m63 = fmaxf(m, CM63[c]); M63A[c] = m63; m = GG[c] + m63; gs += GG[c]; }
            STme[128 * 256 + 128] = m; STme[128 * 256 + 129] = gs; } }
        __syncthreads();
        chain_run<false>(L, tid0, wid, h, row0, c0, QKc, MV, MLO, GS, acc);
        { CH_FRESH();
#pragma unroll
            for (int Td = 0; Td < 4; ++Td)
#pragma unroll
                for (int r = 0; r < 16; ++r) STme[((wid * 4 + Td) * 16 + r) * 64 + lane] = acc[Td][r];
            if (tid < 128) STme[128 * 256 + tid] = NV[tid];
            asm volatile("s_waitcnt vmcnt(0)" ::: "memory");
            __syncthreads();
            if (tid == 0) { __builtin_amdgcn_fence(__ATOMIC_RELEASE, "agent"); asm volatile("s_waitcnt vmcnt(0)" ::: "memory"); __hip_atomic_store(flags + 16 * seg, 1u, __ATOMIC_RELAXED, __HIP_MEMORY_SCOPE_AGENT); }
        }
    }
    float m0 = 0.f;
    {   CH_FRESH();
        if (seg > 0) {
            if (tid == 0) {
                for (int j = 0; j < seg; ++j) { unsigned sp = 0; while (__hip_atomic_load(flags + 16 * j, __ATOMIC_RELAXED, __HIP_MEMORY_SCOPE_AGENT) == 0u && ++sp < (1u << 22)) __builtin_amdgcn_s_sleep(2); }
                __builtin_amdgcn_fence(__ATOMIC_ACQUIRE, "agent"); asm volatile("s_waitcnt vmcnt(0)" ::: "memory");
            }
            __syncthreads();
        }
#pragma unroll
        for (int i = 0; i < 4; ++i) acc[i] = f32x16{};
        float nreg = 0.f;
#pragma unroll 1
        for (int j = 0; j < seg; ++j) { const float* Sj = STbh + (size_t)j * ST_FLOATS;
            const float ml = __builtin_nontemporal_load(Sj + 128 * 256 + 128), gsum = __builtin_nontemporal_load(Sj + 128 * 256 + 129);
            const float mn = fmaxf(gsum + m0, ml); const float fa = __expf(gsum + m0 - mn), fb = __expf(ml - mn);
#pragma unroll
            for (int Td = 0; Td < 4; ++Td)
#pragma unroll
                for (int r = 0; r < 16; ++r) acc[Td][r] = fa * acc[Td][r] + fb * Sj[((wid * 4 + Td) * 16 + r) * 64 + lane];
            if (tid < 128) nreg = fa * nreg + fb * Sj[128 * 256 + tid];
            m0 = mn; }
        __syncthreads();
        if (tid < 128) NV[tid] = nreg;
        if (tid == 0) { float m = m0;
            for (int c = 0; c < CPS; ++c) { MC[c] = m; const float m63 = fmaxf(m, CM63[c]); M63A[c] = m63; m = GG[c] + m63; } }
        __syncthreads();
    }
    chain_run<true>(L, tid0, wid, h, row0, c0, QKc, MV, MLO, GS, acc);
#undef CH_FRESH
}
}
#define RLX_AGENT __ATOMIC_RELAXED, __HIP_MEMORY_SCOPE_AGENT
#define LDS_WAIT() asm volatile("s_waitcnt lgkmcnt(0)" ::: "memory")
#define VM_WAIT() asm volatile("s_waitcnt vmcnt(0)" ::: "memory")
#define XB_TMO      128
#define XB_XCNT(j)  (256  + 64 * (j))
#define XB_XSUB(j)  (1280 + 64 * (j))
#define XB_XGEN(j)  (2304 + 64 * (j))
#define XB_TOP      3328
#define XB_TOPGEN   3392
#define XCD_BAR_WORDS 3456
#define XB_SPIN_CAP (1u << 18)

__device__ __forceinline__ unsigned xb_ld(unsigned* p)              { return __hip_atomic_load(p, __ATOMIC_RELAXED, __HIP_MEMORY_SCOPE_AGENT); }
__device__ __forceinline__ unsigned xb_add(unsigned* p, unsigned v) { return __hip_atomic_fetch_add(p, v, __ATOMIC_RELAXED, __HIP_MEMORY_SCOPE_AGENT); }
__device__ __forceinline__ unsigned xb_xcc_id() { return (unsigned)__builtin_amdgcn_s_getreg((3 << 11) | 20) & 0xFu; }
#define XB_SPIN(cond, bar) do { unsigned _sp = 0; while (cond) { __builtin_amdgcn_s_sleep(1); \
    if ((++_sp & 255u) == 0u) { if (xb_ld(&(bar)[XB_TMO])) break; if (_sp > XB_SPIN_CAP) { atomicAdd(&(bar)[XB_TMO], 1u); break; } } } } while (0)

struct XcdBarrier {
    unsigned* bar; unsigned x;
    volatile LAS unsigned* st;
};

__device__ __forceinline__ XcdBarrier xcd_barrier_post(unsigned* bar, volatile LAS unsigned* st) {
    XcdBarrier b; b.bar = bar; b.x = xb_xcc_id(); b.st = st;
    if (threadIdx.x == 0) (void)xb_add(&bar[XB_XCNT(b.x)], 1u);
    return b;
}
__device__ __forceinline__ void xcd_barrier_complete(unsigned* bar, unsigned x, unsigned& nloc, unsigned& nx) {
    const unsigned G = gridDim.x * gridDim.y * gridDim.z;
    unsigned sum, cnt, mine, sp = 0u;
    for (;;) {
        sum = 0u; cnt = 0u; mine = 0u;
#pragma unroll
        for (unsigned j = 0; j < 16; ++j) { const unsigned c = xb_ld(&bar[XB_XCNT(j)]); sum += c; cnt += (c > 0u) ? 1u : 0u; mine = (j == x) ? c : mine; }
        if (sum == G) break;
        __builtin_amdgcn_s_sleep(1);
        if ((++sp & 255u) == 0u) { if (xb_ld(&bar[XB_TMO])) break; if (sp > XB_SPIN_CAP) { atomicAdd(&bar[XB_TMO], 1u); break; } }
    }
    nloc = mine > 0u ? mine : 1u; nx = cnt > 0u ? cnt : 1u;
}

__device__ __forceinline__ void xcd_barrier(const XcdBarrier& b) {
    asm volatile("s_waitcnt vmcnt(0)" ::: "memory");
    __syncthreads();
    if (threadIdx.x == 0) {
        unsigned* bar = b.bar;
        __builtin_amdgcn_s_waitcnt(0);
        unsigned nloc = b.st[0], nx = b.st[1];
        if (nloc == 0u) { xcd_barrier_complete(bar, b.x, nloc, nx); b.st[0] = nloc; b.st[1] = nx; }
        const unsigned old = xb_add(&bar[XB_XSUB(b.x)], 1u);
        const unsigned gen = old / nloc;
        if (old + 1u == (gen + 1u) * nloc) {
            __builtin_amdgcn_fence(__ATOMIC_RELEASE, "agent");
            asm volatile("s_waitcnt vmcnt(0)" ::: "memory");
            const unsigned og = xb_add(&bar[XB_TOP], 1u);
            const unsigned tg = og / nx;
            if (og + 1u == (tg + 1u) * nx) xb_add(&bar[XB_TOPGEN], 1u);
            else XB_SPIN(xb_ld(&bar[XB_TOPGEN]) == tg, bar);
            __builtin_amdgcn_fence(__ATOMIC_ACQUIRE, "agent");
            xb_add(&bar[XB_XGEN(b.x)], 1u);
            asm volatile("s_waitcnt vmcnt(0)" ::: "memory");
        } else {
            XB_SPIN(xb_ld(&bar[XB_XGEN(b.x)]) == gen, bar);
            __builtin_amdgcn_fence(__ATOMIC_ACQUIRE, "agent");
            asm volatile("s_waitcnt vmcnt(0)" ::: "memory");
        }
    }
    __syncthreads();
}

__device__ const unsigned short ATT_ORDER[512] = {484,492,500,508,485,493,501,509,486,494,502,510,487,495,503,511,452,460,468,476,453,461,469,477,454,462,470,478,455,463,471,479,420,428,436,444,421,429,437,445,422,430,438,446,423,431,439,447,388,396,404,412,389,397,405,413,390,398,406,414,391,399,407,415,356,364,372,380,357,365,373,381,358,366,374,382,359,367,375,383,324,332,340,348,325,333,341,349,326,334,342,350,327,335,343,351,292,300,308,316,293,301,309,317,294,302,310,318,295,303,311,319,483,491,499,507,451,459,467,475,419,427,435,443,387,395,403,411,355,363,371,379,323,331,339,347,291,299,307,315,259,267,275,283,260,268,276,284,261,269,277,285,262,270,278,286,263,271,279,287,227,235,243,251,228,236,244,252,229,237,245,253,230,238,246,254,231,239,247,255,195,203,211,219,196,204,212,220,197,205,213,221,198,206,214,222,199,207,215,223,163,171,179,187,164,172,180,188,165,173,181,189,166,174,182,190,167,175,183,191,482,490,498,506,450,458,466,474,418,426,434,442,386,394,402,410,354,362,370,378,322,330,338,346,290,298,306,314,258,266,274,282,226,234,242,250,194,202,210,218,162,170,178,186,130,138,146,154,131,139,147,155,132,140,148,156,133,141,149,157,134,142,150,158,135,143,151,159,98,106,114,122,99,107,115,123,100,108,116,124,101,109,117,125,102,110,118,126,103,111,119,127,481,489,497,505,449,457,465,473,417,425,433,441,385,393,401,409,353,361,369,377,321,329,337,345,289,297,305,313,257,265,273,281,225,233,241,249,193,201,209,217,161,169,177,185,129,137,145,153,97,105,113,121,65,73,81,89,66,74,82,90,67,75,83,91,68,76,84,92,69,77,85,93,70,78,86,94,71,79,87,95,480,488,496,504,448,456,464,472,416,424,432,440,384,392,400,408,352,360,368,376,320,328,336,344,288,296,304,312,256,264,272,280,224,232,240,248,192,200,208,216,160,168,176,184,128,136,144,152,96,104,112,120,64,72,80,88,32,40,48,56,33,41,49,57,34,42,50,58,35,43,51,59,36,44,52,60,37,45,53,61,38,46,54,62,39,47,55,63,0,8,16,24,1,9,17,25,2,10,18,26,3,11,19,27,4,12,20,28,5,13,21,29,6,14,22,30,7,15,23,31};
struct Args { const float* in[17]; float* out; unsigned char* ws; };
enum { I_X = 0, I_NMIX, I_WIN, I_BGATES, I_CONVW, I_CONVB, I_LAM, I_DANG, I_MLNG, I_BMERGE, I_WA, I_WM, I_WOUT, I_NMLP, I_WFF1, I_WFF2, I_NFIN };

__global__ void __launch_bounds__(NTHR, 2) mk_fwd(Args a) {
    extern __shared__ __attribute__((aligned(16))) unsigned char lds[];
    cg::grid_group grid = cg::this_grid();
    LAS unsigned char* L = (LAS unsigned char*)lds;
    volatile LAS unsigned* MISC = (volatile LAS unsigned*)(L + MISC_OFF);
    const int wave = __builtin_amdgcn_readfirstlane(threadIdx.x >> 6);
    const int G = gridDim.x, bx = blockIdx.x;
    const int gw = bx * NWAVES + wave, NGW = G * NWAVES;
    unsigned char* ws = a.ws;
    if (threadIdx.x < 32) MISC[threadIdx.x] = 0u;
    __syncthreads();
    XcdBarrier xbar = xcd_barrier_post((unsigned*)(ws + WS_CTL + 16384), MISC + 8);
    const float* x = a.in[I_X];
    bf16* WINT = (bf16*)(ws + WS_WIN); bf16* W1T = (bf16*)(ws + WS_W1T); bf16* W2T = (bf16*)(ws + WS_W2T);
    bf16* XN = (bf16*)(ws + WS_XN); bf16* QKC = XN;
    bf16* B0 = (bf16*)(ws + WS_B0); bf16* B1 = (bf16*)(ws + WS_B0 + WS_BSTR); bf16* B2 = (bf16*)(ws + WS_B0 + 2 * WS_BSTR); bf16* B3 = (bf16*)(ws + WS_B0 + 3 * WS_BSTR);
    bf16* B4 = (bf16*)(ws + WS_B0 + 4 * WS_BSTR); bf16* B5 = (bf16*)(ws + WS_B0 + 5 * WS_BSTR);
    bf16* HB = (bf16*)(ws + WS_H);
    bf16* WAT = (bf16*)(ws + WS_WAT); bf16* WMT = (bf16*)(ws + WS_WMT); bf16* WOT = (bf16*)(ws + WS_WOT);
    float* IFG = (float*)(ws + WS_IF);
    unsigned* CTL = (unsigned*)(ws + WS_CTL); float* RSQ1 = (float*)(ws + WS_CTL + 65536); float* RSQ2 = (float*)(ws + WS_CTL + 131072);
    bf16* GA = (bf16*)a.out; bf16* GM = GA + (size_t)TT * 1024;
    float* OUT = a.out;

    {
        const int tid = fresh_tid(wave), lane = tid & 63;
        LAS float* scr = (LAS float*)(L + wave * 8448);
        LAS float* WIF = (LAS float*)(L + 73728);
        const float* win = a.in[I_WIN];
        for (int i = tid; i < 8192; i += NTHR) WIF[(i & 7) * 1024 + (i >> 3)] = win[(size_t)(i >> 3) * DIN + 5120 + (i & 7)];
        for (int it = gw; it < 16 * 256; it += NGW) { const int kb = it >> 8, nb = it & 255; const int nd0 = 32 * nb, ns0 = nd0 + (nd0 >= 5120 ? 8 : 0);
            transpose_item(win, DIN, 1024, WINT, nd0, ns0, 64 * kb, nullptr, scr, lane); }
        __syncthreads();
        const float* gmix = a.in[I_NMIX]; const float* bg = a.in[I_BGATES];
        f32x4 gv[4];
#pragma unroll
        for (int j = 0; j < 4; ++j) gv[j] = *((const f32x4*)gmix + lane + 64 * j);
        f32x4 nx[4];
        if (gw < TT) {
#pragma unroll
            for (int j = 0; j < 4; ++j) nx[j] = __builtin_nontemporal_load((const f32x4*)(x + (size_t)gw * 1024) + lane + 64 * j); }
        for (int m = gw; m < TT; m += NGW) {
            f32x4 v[4]; float s = 0.f;
#pragma unroll
            for (int j = 0; j < 4; ++j) v[j] = nx[j];
            if (m + NGW < TT) {
#pragma unroll
                for (int j = 0; j < 4; ++j) nx[j] = __builtin_nontemporal_load((const f32x4*)(x + (size_t)(m + NGW) * 1024) + lane + 64 * j); }
#pragma unroll
            for (int j = 0; j < 4; ++j) s += (v[j].x * v[j].x + v[j].y * v[j].y) + (v[j].z * v[j].z + v[j].w * v[j].w);
            const float rstd = 1.f / sqrtf(wave_sum(s) * (1.f / 1024.f) + EPSN);
            float g8[8];
#pragma unroll
            for (int q = 0; q < 8; ++q) g8[q] = 0.f;
            unsigned long long* o8 = (unsigned long long*)(XN + (size_t)m * 1024) + lane;
#pragma unroll
            for (int j = 0; j < 4; ++j) { v[j] = v[j] * rstd * gv[j];
                o8[64 * j] = (unsigned long long)pk2(v[j].x, v[j].y) | ((unsigned long long)pk2(v[j].z, v[j].w) << 32);
#pragma unroll
                for (int q = 0; q < 8; ++q) { const f32x4 w = *(LAS const f32x4*)(WIF + q * 1024 + 256 * j + 4 * lane); g8[q] += (v[j][0] * w[0] + v[j][1] * w[1]) + (v[j][2] * w[2] + v[j][3] * w[3]); } }
            float mine = 0.f;
#pragma unroll
            for (int q = 0; q < 8; ++q) { const float sv = wave_sum(g8[q]); if (lane == q) mine = sv; }
            if (lane < 8) IFG[(size_t)m * 8 + lane] = mine + bg[lane];
        }
    }
    xcd_barrier(xbar);
    if (a.ws == nullptr) grid.sync();

    {
        pg8::Gemm g{XN, WINT, TT, 8192, 1024}; pg8::StaticOrder S; S.init(TT, 8192, G, bx);
        pg8::EpiProj E{B0, GA, (size_t)TT * 1024, a.in[I_BMERGE], attn_body::C2, a.in[I_MLNG], CTL + 12288};
        pg8::gemm_phase<pg8::EpiProj, pg8::StaticOrder, true, true>(L, g, S, E, wave);
    }
    xcd_barrier(xbar);


    {
        const int tid = fresh_tid(wave), lane = tid & 63;
        const float* cw = a.in[I_CONVW]; const float* cb = a.in[I_CONVB];
        const bf16* MLQK = B3;
#pragma unroll 2
        for (int it = bx * NTHR + tid; it < TT * 128; it += G * NTHR) {
            const int row = it >> 7, c0 = (it & 127) * 8, tp = row & (SEQ - 1);
            float acc[8];
            { const f32x4 b0 = *(const f32x4*)(cb + c0), b1 = *(const f32x4*)(cb + c0 + 4); acc[0] = b0[0]; acc[1] = b0[1]; acc[2] = b0[2]; acc[3] = b0[3]; acc[4] = b1[0]; acc[5] = b1[1]; acc[6] = b1[2]; acc[7] = b1[3]; }
#pragma unroll
            for (int j = 0; j < 4; ++j) if (tp - 3 + j >= 0) {
                const v4u u = *(const v4u*)(MLQK + (size_t)(row - 3 + j) * 1024 + c0); const f32x4 w0 = *(const f32x4*)(cw + j * 1024 + c0), w1 = *(const f32x4*)(cw + j * 1024 + c0 + 4);
                acc[0] += w0[0] * bflo(u.x); acc[1] += w0[1] * bfhi(u.x); acc[2] += w0[2] * bflo(u.y); acc[3] += w0[3] * bfhi(u.y);
                acc[4] += w1[0] * bflo(u.z); acc[5] += w1[1] * bfhi(u.z); acc[6] += w1[2] * bflo(u.w); acc[7] += w1[3] * bfhi(u.w); }
            const float sc = (c0 < 512) ? 0.08838834764831845f : 1.f;
#pragma unroll
            for (int i = 0; i < 8; ++i) acc[i] = acc[i] * pg8::sigm(acc[i]) * sc;
            v4u o; o.x = cvtpk(acc[0], acc[1]); o.y = cvtpk(acc[2], acc[3]); o.z = cvtpk(acc[4], acc[5]); o.w = cvtpk(acc[6], acc[7]);
            *(v4u*)(QKC + (size_t)row * 1024 + c0) = o;
        }
    }
    xcd_barrier(xbar);

    {
        const int tid = fresh_tid(wave), lane = tid & 63;
#ifndef NO_CHAIN
        if (bx < 16 * mls::NSEG) { const int bh = bx & 15, seg = bx >> 4; unsigned char* scr = ws + WS_B0 + 3 * WS_BSTR + 16 * MiB;
            mls::chain(L, bh >> 2, bh & 3, seg, QKC, B4, B5, IFG, a.in[I_MLNG], (f32x4*)scr + (size_t)bh * 4096, (float*)(scr + MiB) + (size_t)bh * (mls::NSEG - 1) * mls::ST_FLOATS, CTL + 8192 + bh * 16 * mls::NSEG, wave); }
#endif
        const float* lam = a.in[I_LAM]; float s1 = 0.f, s2 = 0.f;
        for (int k = 0; k < 64; ++k) { s1 += lam[k] * lam[64 + k]; s2 += lam[128 + k] * lam[192 + k]; }
        const float lamf = __expf(s1) - __expf(s2) + 0.2f;
        bf16* OT = B3 + (size_t)bx * (2 * 256 * 64);
        const float* dag = a.in[I_DANG];
        for (;;) {
            if (fresh_tid(wave) == 0) MISC[0] = atomicAdd(CTL, 1u);
            __syncthreads();
            const int item = __builtin_amdgcn_readfirstlane((int)MISC[0]);
            __syncthreads();
            if (item >= 512) break;
            const int code = ATT_ORDER[item];
            const int qb = code >> 5, b = (code >> 3) & 3, h = code & 7;
            const float sl2 = exp2f(-(float)(h + 1)) * 1.4426950408889634f;
            const size_t grow0 = (size_t)b * SEQ + (size_t)qb * 256;
            typedef attn_body::bf16 abf;
#ifndef NO_ATTN
#pragma unroll 1
            for (int m = 0; m < 2; ++m) {
                int t0 = 0; float mref = 0.f;
                { const unsigned* np_ = CTL + 12288 + (b * 16 + 2 * h + m) * 4;
                  const float bq2 = __uint_as_float(__hip_atomic_load(np_ + 0, __ATOMIC_RELAXED, __HIP_MEMORY_SCOPE_AGENT)) + __uint_as_float(__hip_atomic_load(np_ + 1, __ATOMIC_RELAXED, __HIP_MEMORY_SCOPE_AGENT));
                  const float bk2 = __uint_as_float(__hip_atomic_load(np_ + 2, __ATOMIC_RELAXED, __HIP_MEMORY_SCOPE_AGENT)) + __uint_as_float(__hip_atomic_load(np_ + 3, __ATOMIC_RELAXED, __HIP_MEMORY_SCOPE_AGENT));
                  mref = 1.01f * sqrtf(bq2 * bk2);
                  const float dmin = (152.f + 2.02f * sqrtf(bq2 * bk2)) / sl2;
                  const float tf = floorf(((float)(qb * 256 + 1) - dmin) * (1.f / 64.f));
                  int ti = tf > 0.f ? (int)tf : 0; if (ti > 4 * qb) ti = 4 * qb; t0 = __builtin_amdgcn_readfirstlane(ti & ~1); }
                if (m == 0) attn_body::attn_unit<64>(b, 2 * h, h * 128, qb, t0, sl2, mref, (const abf*)B0, (const abf*)B1, (const abf*)B2, (abf*)OT, 128, (char*)lds, wave);
                else        attn_body::attn_unit<64>(b, 2 * h + 1, h * 128, qb, t0, sl2, mref, (const abf*)B0, (const abf*)B1, (const abf*)B2, (abf*)(B0 + grow0 * 1024 + h * 128), 1024, (char*)lds, wave);
            }
#endif
            asm volatile("s_waitcnt vmcnt(0)" ::: "memory");
            __syncthreads();
#ifndef NO_COMB
            {
                const int tidc = fresh_tid(wave); const int row = tidc >> 1, j = tidc & 1; const size_t grow = grow0 + row;
                const bf16* p0 = OT + row * 128 + 64 * j;
                const bf16* p1 = B0 + grow * 1024 + h * 128 + 64 * j;
                float av[64]; float ss = 0.f;
#pragma unroll
                for (int c8 = 0; c8 < 8; ++c8) { const v4u u0 = *(const v4u*)(p0 + 8 * c8), u1 = *(const v4u*)(p1 + 8 * c8);
                    av[8 * c8 + 0] = bflo(u0.x) - lamf * bflo(u1.x); av[8 * c8 + 1] = bfhi(u0.x) - lamf * bfhi(u1.x); av[8 * c8 + 2] = bflo(u0.y) - lamf * bflo(u1.y); av[8 * c8 + 3] = bfhi(u0.y) - lamf * bfhi(u1.y);
                    av[8 * c8 + 4] = bflo(u0.z) - lamf * bflo(u1.z); av[8 * c8 + 5] = bfhi(u0.z) - lamf * bfhi(u1.z); av[8 * c8 + 6] = bflo(u0.w) - lamf * bflo(u1.w); av[8 * c8 + 7] = bfhi(u0.w) - lamf * bfhi(u1.w); }
#pragma unroll
                for (int i = 0; i < 64; ++i) ss += av[i] * av[i];
                ss += sx(ss, 1);
                const float rs = __builtin_amdgcn_rsqf(ss * (1.f / 128.f) + EPSN) * 0.8f;
                bf16* dst = B0 + grow * 1024 + h * 128 + 64 * j; const float* gp = dag + h * 128 + 64 * j;
#pragma unroll
                for (int c8 = 0; c8 < 8; ++c8) { const f32x4 g0 = *(const f32x4*)(gp + 8 * c8), g1 = *(const f32x4*)(gp + 8 * c8 + 4); v4u o;
                    o.x = cvtpk(av[8 * c8 + 0] * rs * g0[0], av[8 * c8 + 1] * rs * g0[1]); o.y = cvtpk(av[8 * c8 + 2] * rs * g0[2], av[8 * c8 + 3] * rs * g0[3]);
                    o.z = cvtpk(av[8 * c8 + 4] * rs * g1[0], av[8 * c8 + 5] * rs * g1[1]); o.w = cvtpk(av[8 * c8 + 6] * rs * g1[2], av[8 * c8 + 7] * rs * g1[3]);
                    *(v4u*)(dst + 8 * c8) = o; }
            }
#endif
            asm volatile("s_waitcnt vmcnt(0)" ::: "memory");
            __syncthreads();
        }
        {
            LAS float* scr = (LAS float*)(L + wave * 8448);
            for (;;) {
                if (tid == 0) MISC[0] = atomicAdd(CTL + 32, 1u);
                __syncthreads();
                const int wi = __builtin_amdgcn_readfirstlane((int)MISC[0]);
                __syncthreads();
                if (wi >= 704) break;
                int r = wi * 8 + wave;
                if (r < 512) { transpose_item(a.in[I_WA], 1024, 1024, WAT, 32 * (r & 31), 32 * (r & 31), 64 * (r >> 5), nullptr, scr, lane); continue; } r -= 512;
                if (r < 512) { transpose_item(a.in[I_WM], 1024, 1024, WMT, 32 * (r & 31), 32 * (r & 31), 64 * (r >> 5), nullptr, scr, lane); continue; } r -= 512;
                if (r < 512) { transpose_item(a.in[I_WOUT], 1024, 1024, WOT, 32 * (r & 31), 32 * (r & 31), 64 * (r >> 5), nullptr, scr, lane); continue; } r -= 512;
                if (r < 2048) { transpose_item(a.in[I_WFF1], 4096, 1024, W1T, 32 * (r & 127), 32 * (r & 127), 64 * (r >> 7), a.in[I_NMLP], scr, lane); continue; } r -= 2048;
                transpose_item(a.in[I_WFF2], 1024, 4096, W2T, 32 * (r & 31), 32 * (r & 31), 64 * (r >> 5), nullptr, scr, lane);
            }
        }
    }
    xcd_barrier(xbar);

    {
        pg8::StaticOrder S; S.init(TT, 1024, G, bx);
        { pg8::Gemm g{B0, WAT, TT, 1024, 1024}; pg8::EpiGate<false> E{GA, nullptr, B1}; pg8::gemm_phase<pg8::EpiGate<false>, pg8::StaticOrder, true, true>(L, g, S, E, wave); }
        { pg8::Gemm g{B4, WMT, TT, 1024, 1024}; pg8::EpiGate<true> E{GM, B1, B2}; pg8::gemm_phase<pg8::EpiGate<true>, pg8::StaticOrder, true, true>(L, g, S, E, wave); }
    }
    xcd_barrier(xbar);

    {
        pg8::Gemm g{B2, WOT, TT, 1024, 1024}; pg8::StaticOrder S; S.init(TT, 1024, G, bx);
        pg8::EpiRes E{x, (G == 256) ? nullptr : OUT, B5, RSQ1};
        pg8::gemm_phase<pg8::EpiRes, pg8::StaticOrder, true, true>(L, g, S, E, wave);
    }
    xcd_barrier(xbar);

    {
        pg8::Gemm g{B5, W1T, TT, 4096, 1024}; pg8::StaticOrder S; S.init(TT, 4096, G, bx);
        pg8::EpiFF1 E{HB, RSQ1, EPSN};
        pg8::gemm_phase<pg8::EpiFF1, pg8::StaticOrder, true, true>(L, g, S, E, wave);
    }
    xcd_barrier(xbar);

    if (G == 256) {
        pg8::Gemm g{HB, W2T, TT, 1024, 4096}; pg8::StaticOrder S; S.init(TT, 1024, G, bx);
        pg8::EpiFinal E{B5, OUT, a.in[I_NFIN], (float*)(ws + WS_CTL + CTL_BYTES), CTL + 49152, EPSN};
        pg8::gemm_phase<pg8::EpiFinal, pg8::StaticOrder, false, true>(L, g, S, E, wave);
    } else {
    {
        pg8::Gemm g{HB, W2T, TT, 1024, 4096}; pg8::StaticOrder S; S.init(TT, 1024, G, bx);
        pg8::EpiRes E{OUT, OUT, nullptr, RSQ2};
        pg8::gemm_phase<pg8::EpiRes, pg8::StaticOrder, true, true>(L, g, S, E, wave);
    }
    xcd_barrier(xbar);

    {
        const int tid = fresh_tid(wave), lane = tid & 63;
        const float* gf = a.in[I_NFIN];
        f32x4 gv[4];
#pragma unroll
        for (int j = 0; j < 4; ++j) gv[j] = *((const f32x4*)gf + lane + 64 * j);
        for (int m = gw; m < TT; m += 2 * NGW) {
            const int m2 = m + NGW; const bool has2 = m2 < TT;
            const float rs = __builtin_amdgcn_rsqf(RSQ2[m] * (1.f / 1024.f) + EPSN), rs2 = has2 ? __builtin_amdgcn_rsqf(RSQ2[m2] * (1.f / 1024.f) + EPSN) : 0.f;
            f32x4* xr = (f32x4*)(OUT + (size_t)m * 1024) + lane; f32x4* xr2 = (f32x4*)(OUT + (size_t)(has2 ? m2 : m) * 1024) + lane;
            f32x4 a0[4], a1[4];
#pragma unroll
            for (int j = 0; j < 4; ++j) { a0[j] = xr[64 * j]; a1[j] = xr2[64 * j]; }
#pragma unroll
            for (int j = 0; j < 4; ++j) { xr[64 * j] = a0[j] * rs * gv[j]; if (has2) xr2[64 * j] = a1[j] * rs2 * gv[j]; }
        }
    }
    }
}

extern "C" void kernel_launch(void* const* d_in, const int* in_sizes, int n_in, void* d_out, int out_size, void* d_ws, size_t ws_size, hipStream_t stream) {
    static int grid = 0;
    if (grid == 0) {
        if (n_in != 17 || out_size != TT * 1024 || ws_size < WS_END) { fprintf(stderr, "kernel_launch: unexpected shapes (n_in %d, out %d, ws %zu)\n", n_in, out_size, ws_size); grid = -1; return; }
        int dev = 0, cus = 0, per_cu = 0;
        hipGetDevice(&dev); hipDeviceGetAttribute(&cus, hipDeviceAttributeMultiprocessorCount, dev);
        if (hipFuncSetAttribute((const void*)mk_fwd, hipFuncAttributeMaxDynamicSharedMemorySize, LDS_BYTES) != hipSuccess) { fprintf(stderr, "kernel_launch: hipFuncSetAttribute failed\n"); grid = -1; return; }
        if (hipOccupancyMaxActiveBlocksPerMultiprocessor(&per_cu, (const void*)mk_fwd, NTHR, LDS_BYTES) != hipSuccess || per_cu < 1) { fprintf(stderr, "kernel_launch: occupancy query gave %d\n", per_cu); per_cu = 1; }
        (void)hipGetLastError();
        grid = cus * per_cu;
    }
    if (grid < 0) return;
    hipMemsetAsync((char*)d_ws + WS_CTL, 0, CTL_BYTES, stream);
    Args a{};
    for (int i = 0; i < 17; ++i) a.in[i] = (const float*)d_in[i];
    a.out = (float*)d_out; a.ws = (unsigned char*)d_ws;
    void* args[] = {&a};
    hipError_t e = hipLaunchCooperativeKernel((const void*)mk_fwd, dim3(grid), dim3(NTHR), args, LDS_BYTES, stream);
    if (e != hipSuccess) fprintf(stderr, "kernel_launch: cooperative launch failed: %s (grid %d)\n", hipGetErrorString(e), grid);
}
```

```cpp
#include <hip/hip_runtime.h>
#include <hip/hip_cooperative_groups.h>
#include <cstdio>
#include <cstdint>
namespace cg = cooperative_groups;
__device__ __forceinline__ int my_lane() { int l_; asm volatile("v_mbcnt_lo_u32_b32 %0, -1, 0\n\tv_mbcnt_hi_u32_b32 %0, -1, %0" : "=v"(l_)); return l_; }
__device__ __forceinline__ int fresh_tid(int wave_s) { return wave_s * 64 + my_lane(); }
__device__ __forceinline__ float sx(float v, int m) { return __builtin_bit_cast(float, __builtin_amdgcn_ds_bpermute((my_lane() ^ m) << 2, __builtin_bit_cast(int, v))); }
namespace pg8 {
#define PG8_LAS __attribute__((address_space(3)))
typedef unsigned short bf16_t;
typedef short bf16x8 __attribute__((ext_vector_type(8)));
typedef float f32x4 __attribute__((ext_vector_type(4)));
typedef unsigned u32x4 __attribute__((ext_vector_type(4)));
constexpr int BM = 256, BK = 64, HALF = 128, HTB = HALF * BK * 2  , STAGE_BYTES = 8 * HTB, NXCD = 8, WGM = 8;

__host__ __device__ __forceinline__ int lds_byte(int r, int c) { const int st = (r >> 4) * 2 + (c >> 5), rr = r & 15, cc = c & 31, ob = rr * 64 + cc * 2; return st * 1024 + (ob ^ (((ob >> 9) & 1) << 5)); }
__host__ __device__ __forceinline__ void stage_rc(int b, int& R, int& C) { const int st = b / 1024, sb = b % 1024, swz = sb ^ (((sb >> 9) & 1) << 5); R = (st >> 1) * 16 + swz / 64; C = (st & 1) * 32 + (swz % 64) / 2; }
__host__ __device__ __forceinline__ int perm32(int rho) { const int n = rho >> 4, i = rho & 15; return 8 * (i >> 2) + 4 * n + (i & 3); }

struct Unit { int pm, pn; };
struct Gemm { const bf16_t* A; const bf16_t* Bt; int M, N, K; };

struct StaticOrder {
    int nM, nN, nwg, G, c;
    __host__ __device__ void init(int M, int N, int G_, int c_) { nM = M / BM; nN = N / BM; nwg = nM * nN; G = G_; c = c_; }
    __host__ __device__ bool next(int i, Unit& u) const {
        const long L = (long)i * G + c; if (L >= nwg) return false;
        int wgid = (int)L; { const int q = nwg / NXCD, r = nwg % NXCD, xcd = wgid % NXCD, off = wgid / NXCD; wgid = (xcd < r ? xcd * (q + 1) : r * (q + 1) + (xcd - r) * q) + off; }
        const int nig = WGM * nN, gid = wgid / nig, fm = gid * WGM, gsz = (nM - fm) < WGM ? (nM - fm) : WGM;
        u.pm = fm + ((wgid % nig) % gsz); u.pn = (wgid % nig) / gsz; return true;
    }
    __device__ __forceinline__ void a_ready(const Unit&) const {}
    __device__ __forceinline__ void done(const Unit&) const {}
};

__device__ __forceinline__ unsigned cvt_pk_bf16(float lo, float hi) { unsigned r; asm volatile("v_cvt_pk_bf16_f32 %0, %1, %2" : "=v"(r) : "v"(lo), "v"(hi)); return r; }
typedef float f32x2 __attribute__((ext_vector_type(2)));
typedef unsigned u32x2 __attribute__((ext_vector_type(2)));
__device__ __forceinline__ float bf_lo(unsigned w) { return __uint_as_float(w << 16); }
__device__ __forceinline__ float bf_hi(unsigned w) { return __uint_as_float(w & 0xffff0000u); }
__device__ __forceinline__ float sigm(float v) { return __builtin_amdgcn_rcpf(1.f + __expf(-v)); }

struct EpiProj {
    static constexpr bool PERM = true, AFTER_DRAIN = false;
    bf16_t* wsb; bf16_t* outb; size_t stride; const float* bmerge; float scale0; const float* mlng; unsigned* nmax;
    __device__ __forceinline__ void operator()(const f32x4 (&acc)[2][2][4][2], const Unit& u, int wr, int wc, int fr, int fq) const {
        const int row0 = u.pm * BM + wr * 64 + fr; int colt = u.pn * BM; const int t = colt >> 10; colt &= 1023;
        bf16_t* base = (t < 6) ? wsb + (size_t)t * stride : outb + (size_t)(t - 6) * stride;
        const float sc = (t == 0) ? scale0 : 1.f; const bool gate = (t >= 6);
        const int col0 = colt + wc * 32 + 8 * fq;
        f32x4 bv[2][2];
#pragma unroll
        for (int bj = 0; bj < 2; ++bj)
#pragma unroll
            for (int n = 0; n < 2; ++n) bv[bj][n] = gate ? *(const f32x4*)(bmerge + (t - 6) * 1024 + col0 + bj * HALF + 4 * n) : (f32x4){0.f, 0.f, 0.f, 0.f};
        float pmax[2] = {0.f, 0.f};
#pragma unroll
        for (int ai = 0; ai < 2; ++ai)
#pragma unroll
            for (int m = 0; m < 4; ++m) { bf16_t* rowp = base + (size_t)(row0 + ai * HALF + m * 16) * 1024 + col0;
#pragma unroll
                for (int bj = 0; bj < 2; ++bj) { f32x4 v0 = acc[ai][bj][m][0] + bv[bj][0], v1 = acc[ai][bj][m][1] + bv[bj][1];
                    if (gate || t == 5) { v0 = (f32x4){sigm(v0[0]), sigm(v0[1]), sigm(v0[2]), sigm(v0[3])}; v1 = (f32x4){sigm(v1[0]), sigm(v1[1]), sigm(v1[2]), sigm(v1[3])}; }
                    if (t == 5) { v0 = v0 * *(const f32x4*)(mlng + col0 + bj * HALF); v1 = v1 * *(const f32x4*)(mlng + col0 + bj * HALF + 4); }
                    v0 = v0 * sc; v1 = v1 * sc; u32x4 w; w.x = cvt_pk_bf16(v0[0], v0[1]); w.y = cvt_pk_bf16(v0[2], v0[3]); w.z = cvt_pk_bf16(v1[0], v1[1]); w.w = cvt_pk_bf16(v1[2], v1[3]);
                    *(u32x4*)(rowp + bj * HALF) = w;
                    if (t < 2) { float ss = (v0[0] * v0[0] + v0[1] * v0[1]) + (v0[2] * v0[2] + v0[3] * v0[3]) + (v1[0] * v1[0] + v1[1] * v1[1]) + (v1[2] * v1[2] + v1[3] * v1[3]);
                        ss += sx(ss, 16); ss += sx(ss, 32); pmax[bj] = fmaxf(pmax[bj], ss); } } }
        if (t < 2) {
#pragma unroll
            for (int bj = 0; bj < 2; ++bj) { float p = pmax[bj]; p = fmaxf(p, sx(p, 1)); p = fmaxf(p, sx(p, 2)); p = fmaxf(p, sx(p, 4)); p = fmaxf(p, sx(p, 8));
                if (fr == 0 && fq == 0) { const int bb_ = (u.pm * BM) >> 12, hm_ = (colt >> 6) + 2 * bj + (wc >> 1); atomicMax(nmax + (((bb_ * 16 + hm_) * 2 + t) * 2 + (wc & 1)), __float_as_uint(p)); } }
        }
    }
};
template <bool ADD> struct EpiGate {
    static constexpr bool PERM = true, AFTER_DRAIN = false;
    const bf16_t* g; const bf16_t* prev; bf16_t* O;
    __device__ __forceinline__ void operator()(const f32x4 (&acc)[2][2][4][2], const Unit& u, int wr, int wc, int fr, int fq) const {
        const int row0 = u.pm * BM + wr * 64 + fr; const int col0 = u.pn * BM + wc * 32 + 8 * fq;
#pragma unroll
        for (int ai = 0; ai < 2; ++ai) {
            u32x4 gw[4][2], pw[4][2];
#pragma unroll
            for (int m = 0; m < 4; ++m)
#pragma unroll
                for (int bj = 0; bj < 2; ++bj) { const size_t off = (size_t)(row0 + ai * HALF + m * 16) * 1024 + col0 + bj * HALF;
                    gw[m][bj] = *(const u32x4*)(g + off); if (ADD) pw[m][bj] = *(const u32x4*)(prev + off); }
            asm volatile("" ::: "memory");
#pragma unroll
            for (int m = 0; m < 4; ++m)
#pragma unroll
                for (int bj = 0; bj < 2; ++bj) { const size_t off = (size_t)(row0 + ai * HALF + m * 16) * 1024 + col0 + bj * HALF; const u32x4 gq = gw[m][bj];
                    f32x4 v0 = acc[ai][bj][m][0], v1 = acc[ai][bj][m][1];
                    v0 = v0 * (f32x4){bf_lo(gq.x), bf_hi(gq.x), bf_lo(gq.y), bf_hi(gq.y)}; v1 = v1 * (f32x4){bf_lo(gq.z), bf_hi(gq.z), bf_lo(gq.w), bf_hi(gq.w)};
                    if (ADD) { const u32x4 pq = pw[m][bj];
                        v0 = v0 + (f32x4){bf_lo(pq.x), bf_hi(pq.x), bf_lo(pq.y), bf_hi(pq.y)}; v1 = v1 + (f32x4){bf_lo(pq.z), bf_hi(pq.z), bf_lo(pq.w), bf_hi(pq.w)}; }
                    u32x4 w; w.x = cvt_pk_bf16(v0[0], v0[1]); w.y = cvt_pk_bf16(v0[2], v0[3]); w.z = cvt_pk_bf16(v1[0], v1[1]); w.w = cvt_pk_bf16(v1[2], v1[3]);
                    *(u32x4*)(O + off) = w; }
            asm volatile("" ::: "memory");
        }
    }
};
struct EpiRes {
    static constexpr bool PERM = false, AFTER_DRAIN = false;
    const float* base; float* out; bf16_t* outb; float* rsq;
    __device__ __forceinline__ void operator()(const f32x4 (&acc)[2][2][4][2], const Unit& u, int wr, int wc, int fr, int fq) const {
        const int col0 = u.pn * BM + wc * 32 + 4 * fq;
#pragma unroll
        for (int ai = 0; ai < 2; ++ai) {
            f32x4 bs[4][2][2];
#pragma unroll
            for (int m = 0; m < 4; ++m) { const size_t off = (size_t)(u.pm * BM + ai * HALF + wr * 64 + m * 16 + fr) * 1024 + col0;
#pragma unroll
                for (int bj = 0; bj < 2; ++bj)
#pragma unroll
                    for (int n = 0; n < 2; ++n) bs[m][bj][n] = *(const f32x4*)(base + off + bj * HALF + n * 16); }
            asm volatile("" ::: "memory");
#pragma unroll
            for (int m = 0; m < 4; ++m) { const int row = u.pm * BM + ai * HALF + wr * 64 + m * 16 + fr; const size_t off = (size_t)row * 1024 + col0; float ss = 0.f;
#pragma unroll
                for (int bj = 0; bj < 2; ++bj)
#pragma unroll
                    for (int n = 0; n < 2; ++n) { const f32x4 v = bs[m][bj][n] + acc[ai][bj][m][n];
                        if (out) *(f32x4*)(out + off + bj * HALF + n * 16) = v;
                        if (outb) { u32x2 w; w.x = cvt_pk_bf16(v[0], v[1]); w.y = cvt_pk_bf16(v[2], v[3]); *(u32x2*)(outb + off + bj * HALF + n * 16) = w; }
                        ss += (v[0] * v[0] + v[1] * v[1]) + (v[2] * v[2] + v[3] * v[3]); }
                ss += sx(ss, 16); ss += sx(ss, 32);
                if (fq == 0) atomicAdd(rsq + row, ss); }
            asm volatile("" ::: "memory");
        }
    }
};
struct EpiFinal {
    static constexpr bool PERM = false, AFTER_DRAIN = true;
    const bf16_t* base; float* out; const float* gain; float* xbuf; unsigned* cnt; float eps;
    __device__ __forceinline__ void fused(f32x4 (&acc)[2][2][4][2], const Unit& u, int wr, int wc, int fr, int fq, PG8_LAS unsigned char* lds, int wid, int lane) const {
        PG8_LAS float* P = (PG8_LAS float*)lds;
        PG8_LAS float* S = (PG8_LAS float*)(lds + 4096);
        PG8_LAS unsigned* flag = (PG8_LAS unsigned*)(lds + 5120);
        const int col0 = u.pn * BM + wc * 32 + 4 * fq;
#pragma unroll
        for (int ai = 0; ai < 2; ++ai)
#pragma unroll
            for (int m = 0; m < 4; ++m) { const int rl = ai * HALF + wr * 64 + m * 16 + fr; const size_t off = (size_t)(u.pm * BM + rl) * 1024 + col0; float ss = 0.f;
#pragma unroll
                for (int bj = 0; bj < 2; ++bj)
#pragma unroll
                    for (int n = 0; n < 2; ++n) { const u32x2 bw = *(const u32x2*)(base + off + bj * HALF + n * 16); const f32x4 bs = {bf_lo(bw.x), bf_hi(bw.x), bf_lo(bw.y), bf_hi(bw.y)}; const f32x4 v = bs + acc[ai][bj][m][n]; acc[ai][bj][m][n] = v;
                        ss += (v[0] * v[0] + v[1] * v[1]) + (v[2] * v[2] + v[3] * v[3]); }
                ss += sx(ss, 16); ss += sx(ss, 32);
                if (fq == 0) P[rl * 4 + wc] = ss;
                if (m & 1) asm volatile("" ::: "memory"); }
        asm volatile("s_waitcnt lgkmcnt(0)" ::: "memory"); __builtin_amdgcn_s_barrier(); asm volatile("" ::: "memory");
        const int row = wid * 32 + (lane & 31);
        if (lane < 32) { const f32x4 p4 = *(PG8_LAS const f32x4*)(P + row * 4); const float s = (p4[0] + p4[1]) + (p4[2] + p4[3]);
            __hip_atomic_store(xbuf + (size_t)(u.pm * BM + row) * 4 + u.pn, s, __ATOMIC_RELAXED, __HIP_MEMORY_SCOPE_AGENT); }
        asm volatile("s_waitcnt vmcnt(0)" ::: "memory");
        if (lane == 0) __hip_atomic_fetch_add(cnt + 64 * u.pm, 1u, __ATOMIC_RELAXED, __HIP_MEMORY_SCOPE_AGENT);
        if (wid == 0) {
            unsigned sp = 0;
            while ((unsigned)__builtin_amdgcn_readfirstlane(__hip_atomic_load(cnt + 64 * u.pm, __ATOMIC_RELAXED, __HIP_MEMORY_SCOPE_AGENT)) < 32u && ++sp < (1u << 22)) __builtin_amdgcn_s_sleep(2);
            __builtin_amdgcn_fence(__ATOMIC_ACQUIRE, "agent");
            if (lane == 0) flag[0] = 1u;
        }
        asm volatile("s_waitcnt vmcnt(0) lgkmcnt(0)" ::: "memory"); __builtin_amdgcn_s_barrier(); asm volatile("" ::: "memory");
        if (lane < 32) { const float* sl = xbuf + (size_t)(u.pm * BM + row) * 4; float t = 0.f;
#pragma unroll
            for (int q = 0; q < 4; ++q) t += __hip_atomic_load(sl + q, __ATOMIC_RELAXED, __HIP_MEMORY_SCOPE_AGENT);
            S[row] = __builtin_amdgcn_rsqf(t * (1.f / 1024.f) + eps); }
        asm volatile("s_waitcnt lgkmcnt(0)" ::: "memory"); __builtin_amdgcn_s_barrier(); asm volatile("" ::: "memory");
        f32x4 gv[2][2];
#pragma unroll
        for (int bj = 0; bj < 2; ++bj)
#pragma unroll
            for (int n = 0; n < 2; ++n) gv[bj][n] = *(const f32x4*)(gain + col0 + bj * HALF + n * 16);
#pragma unroll
        for (int ai = 0; ai < 2; ++ai)
#pragma unroll
            for (int m = 0; m < 4; ++m) { const int rl = ai * HALF + wr * 64 + m * 16 + fr; const float rs = S[rl]; const size_t off = (size_t)(u.pm * BM + rl) * 1024 + col0;
#pragma unroll
                for (int bj = 0; bj < 2; ++bj)
#pragma unroll
                    for (int n = 0; n < 2; ++n) *(f32x4*)(out + off + bj * HALF + n * 16) = acc[ai][bj][m][n] * rs * gv[bj][n]; }
    }
};
struct EpiFF1 {
    static constexpr bool PERM = true, AFTER_DRAIN = false;
    bf16_t* O; const float* rsq; float eps;
    __device__ __forceinline__ void operator()(const f32x4 (&acc)[2][2][4][2], const Unit& u, int wr, int wc, int fr, int fq) const {
        const int row0 = u.pm * BM + wr * 64 + fr; const int col0 = u.pn * BM + wc * 32 + 8 * fq;
#pragma unroll
        for (int ai = 0; ai < 2; ++ai)
#pragma unroll
            for (int m = 0; m < 4; ++m) { const int row = row0 + ai * HALF + m * 16; const float rs = __builtin_amdgcn_rsqf(rsq[row] * (1.f / 1024.f) + eps);
                bf16_t* rowp = O + (size_t)row * 4096 + col0;
#pragma unroll
                for (int bj = 0; bj < 2; ++bj) { f32x4 v0 = acc[ai][bj][m][0] * rs, v1 = acc[ai][bj][m][1] * rs;
#pragma unroll
                    for (int i = 0; i < 4; ++i) { float a = fmaxf(v0[i], 0.f), b = fmaxf(v1[i], 0.f); v0[i] = a * a; v1[i] = b * b; }
                    u32x4 w; w.x = cvt_pk_bf16(v0[0], v0[1]); w.y = cvt_pk_bf16(v0[2], v0[3]); w.z = cvt_pk_bf16(v1[0], v1[1]); w.w = cvt_pk_bf16(v1[2], v1[3]);
                    *(u32x4*)(rowp + bj * HALF) = w; } }
    }
};
template <class Epi, class Sched, bool ALIGN_EPI = false, bool SP2 = false>
__device__ __forceinline__ void gemm_phase(PG8_LAS unsigned char* lds, const Gemm g, const Sched& S, const Epi& E, const int wave_s) {
    const int tid = fresh_tid(wave_s), wid = __builtin_amdgcn_readfirstlane(tid >> 6), lane = tid & 63, wr = wid >> 2, wc = wid & 3, fr = lane & 15, fq = lane >> 4;
    const int K = g.K, nt = K / BK;
    unsigned voffA[2], voffB[2];
#pragma unroll
    for (int i = 0; i < 2; ++i) { int R, C; stage_rc(tid * 16 + i * 8192, R, C); const int Rb = Epi::PERM ? ((R & ~31) + perm32(R & 31)) : R;
        voffA[i] = (unsigned)(R * K + C) * 2u; voffB[i] = (unsigned)(Rb * K + C) * 2u; }
    const size_t kstep = (size_t)(BK * 2);
    const size_t hstep = (size_t)HALF * K * 2;
    const size_t tstep = 2 * hstep;
    const unsigned ldsw = (unsigned)wid * 1024u;
    const int aoff = lds_byte(wr * 64 + fr, fq * 8), boff = lds_byte(wc * 32 + fr, fq * 8);
#define PG8_SA(b, h) (((b) * 2 + (h)) * HTB)
#define PG8_SB(b, h) ((4 + (b) * 2 + (h)) * HTB)
#define PG8_STAGE(bufoff, gbase, voff) do { _Pragma("unroll") for (int _i = 0; _i < 2; ++_i) \
        __builtin_amdgcn_global_load_lds((const unsigned*)((const char*)(gbase) + (voff)[_i]), (PG8_LAS unsigned*)(lds + (bufoff) + ldsw + _i * 8192), 16, 0, 0); } while (0)
#define PG8_LDA(dst, b, h) do { _Pragma("unroll") for (int m = 0; m < 4; ++m) _Pragma("unroll") for (int k = 0; k < 2; ++k) dst[m][k] = *(const PG8_LAS bf16x8*)(lds + PG8_SA(b, h) + aoff + m * 2048 + k * 1024); } while (0)
#define PG8_LDB(dst, b, h) do { _Pragma("unroll") for (int n = 0; n < 2; ++n) _Pragma("unroll") for (int k = 0; k < 2; ++k) dst[n][k] = *(const PG8_LAS bf16x8*)(lds + PG8_SB(b, h) + boff + n * 2048 + k * 1024); } while (0)
#define PG8_MMA(ai, bj, At, Bt) do { __builtin_amdgcn_s_setprio(1); _Pragma("unroll") for (int m = 0; m < 4; ++m) _Pragma("unroll") for (int n = 0; n < 2; ++n) _Pragma("unroll") for (int k = 0; k < 2; ++k) \
        acc[ai][bj][m][n] = __builtin_amdgcn_mfma_f32_16x16x32_bf16(Bt[n][k], At[m][k], acc[ai][bj][m][n], 0, 0, 0); __builtin_amdgcn_s_setprio(0); } while (0)
#define PG8_WAIT_V(n) asm volatile("s_waitcnt vmcnt(" #n ")" ::: "memory")
#define PG8_WAIT_L(n) asm volatile("s_waitcnt lgkmcnt(" #n ")" ::: "memory")
#define PG8_BAR __builtin_amdgcn_s_barrier()
#define PG8_SCHED __builtin_amdgcn_sched_barrier(0)
    Unit cur, nxt; int ui = 0;
    if (!S.next(0, cur)) return;
    f32x4 acc[2][2][4][2];
#pragma unroll
    for (int a = 0; a < 2; ++a)
#pragma unroll
        for (int b = 0; b < 2; ++b)
#pragma unroll
            for (int m = 0; m < 4; ++m)
#pragma unroll
                for (int n = 0; n < 2; ++n) acc[a][b][m][n] = (f32x4){0.f, 0.f, 0.f, 0.f};
    bf16x8 At[4][2], B0[2][2], B1[2][2];
    const char* cA = (const char*)g.A + (size_t)cur.pm * tstep; const char* cB = (const char*)g.Bt + (size_t)cur.pn * tstep;
    S.a_ready(cur);
    if constexpr (SP2) {
        PG8_STAGE(PG8_SB(0, 0), cB, voffB); PG8_STAGE(PG8_SB(0, 1), cB + hstep, voffB); PG8_STAGE(PG8_SA(0, 0), cA, voffA); PG8_STAGE(PG8_SA(0, 1), cA + hstep, voffA);
        if (wr == 1) PG8_BAR;
        PG8_WAIT_V(2); PG8_BAR;
        PG8_STAGE(PG8_SB(1, 0), cB + kstep, voffB); PG8_STAGE(PG8_SA(1, 0), cA + kstep, voffA); PG8_STAGE(PG8_SB(1, 1), cB + hstep + kstep, voffB);
        PG8_WAIT_V(6); PG8_BAR;
    } else {
        PG8_STAGE(PG8_SB(0, 0), cB, voffB); PG8_STAGE(PG8_SA(0, 0), cA, voffA); PG8_STAGE(PG8_SB(0, 1), cB + hstep, voffB); PG8_STAGE(PG8_SA(0, 1), cA + hstep, voffA);
        if (wr == 1) PG8_BAR;
        PG8_WAIT_V(4); PG8_BAR;
        PG8_STAGE(PG8_SB(1, 0), cB + kstep, voffB); PG8_STAGE(PG8_SA(1, 0), cA + kstep, voffA); PG8_STAGE(PG8_SB(1, 1), cB + hstep + kstep, voffB);
        PG8_WAIT_V(6); PG8_BAR;
    }
    for (;;) {
        const bool has_next = S.next(ui + 1, nxt);
        const char* nA = has_next ? (const char*)g.A + (size_t)nxt.pm * tstep : cA; const char* nB = has_next ? (const char*)g.Bt + (size_t)nxt.pn * tstep : cB;
        for (int t = 0; t < nt; t += 2) {
            const bool last = (t == nt - 2);
            const char* a1 = cA + (size_t)(t + 1) * kstep;
            const char* a2 = last ? nA : cA + (size_t)(t + 2) * kstep; const char* b2 = last ? nB : cB + (size_t)(t + 2) * kstep;
            const char* a3 = a2 + kstep; const char* b3 = b2 + kstep;
            if (last && has_next) S.a_ready(nxt);
            if constexpr (SP2) {
            PG8_LDB(B0, 0, 0); PG8_LDB(B1, 0, 1); PG8_SCHED; PG8_LDA(At, 0, 0); PG8_STAGE(PG8_SA(1, 1), a1 + hstep, voffA);
            PG8_WAIT_V(8); PG8_WAIT_L(0); PG8_BAR; PG8_MMA(0, 0, At, B0); PG8_MMA(0, 1, At, B1); PG8_BAR; PG8_SCHED;
            PG8_LDA(At, 0, 1); PG8_STAGE(PG8_SB(0, 0), b2, voffB); PG8_STAGE(PG8_SB(0, 1), b2 + hstep, voffB); PG8_STAGE(PG8_SA(0, 0), a2, voffA);
            PG8_WAIT_V(8); PG8_WAIT_L(0); PG8_BAR; PG8_MMA(1, 0, At, B0); PG8_MMA(1, 1, At, B1); PG8_BAR; PG8_SCHED;
            PG8_LDB(B0, 1, 0); PG8_LDB(B1, 1, 1); PG8_SCHED; PG8_LDA(At, 1, 0); PG8_STAGE(PG8_SA(0, 1), a2 + hstep, voffA);
            PG8_WAIT_V(8); PG8_WAIT_L(0); PG8_BAR; PG8_MMA(0, 0, At, B0); PG8_MMA(0, 1, At, B1); PG8_BAR; PG8_SCHED;
            PG8_LDA(At, 1, 1); PG8_STAGE(PG8_SB(1, 0), b3, voffB); PG8_STAGE(PG8_SB(1, 1), b3 + hstep, voffB); PG8_STAGE(PG8_SA(1, 0), a3, voffA);
            PG8_WAIT_V(8); PG8_WAIT_L(0); PG8_BAR; PG8_MMA(1, 0, At, B0); PG8_MMA(1, 1, At, B1); PG8_BAR; PG8_SCHED;
            } else {
            PG8_LDB(B0, 0, 0); PG8_SCHED; PG8_LDA(At, 0, 0); PG8_STAGE(PG8_SA(1, 1), a1 + hstep, voffA);
            PG8_WAIT_L(8); PG8_BAR; PG8_WAIT_L(0); PG8_MMA(0, 0, At, B0); PG8_BAR; PG8_SCHED;
            PG8_LDB(B1, 0, 1); PG8_STAGE(PG8_SB(0, 0), b2, voffB);
            PG8_BAR; PG8_WAIT_L(0); PG8_MMA(0, 1, At, B1); PG8_BAR;
            PG8_LDA(At, 0, 1); PG8_STAGE(PG8_SA(0, 0), a2, voffA);
            PG8_BAR; PG8_WAIT_L(0); PG8_MMA(1, 0, At, B0); PG8_BAR; PG8_SCHED;
            PG8_STAGE(PG8_SB(0, 1), b2 + hstep, voffB);
            PG8_WAIT_V(6); PG8_BAR; PG8_MMA(1, 1, At, B1); PG8_BAR;
            PG8_LDB(B0, 1, 0); PG8_SCHED; PG8_LDA(At, 1, 0); PG8_STAGE(PG8_SA(0, 1), a2 + hstep, voffA);
            PG8_WAIT_L(8); PG8_BAR; PG8_WAIT_L(0); PG8_MMA(0, 0, At, B0); PG8_BAR; PG8_SCHED;
            PG8_LDB(B1, 1, 1); PG8_STAGE(PG8_SB(1, 0), b3, voffB);
            PG8_BAR; PG8_WAIT_L(0); PG8_MMA(0, 1, At, B1); PG8_BAR;
            PG8_LDA(At, 1, 1); PG8_STAGE(PG8_SA(1, 0), a3, voffA);
            PG8_BAR; PG8_WAIT_L(0); PG8_MMA(1, 0, At, B0); PG8_BAR; PG8_SCHED;
            PG8_STAGE(PG8_SB(1, 1), b3 + hstep, voffB);
            PG8_WAIT_V(6); PG8_BAR; PG8_MMA(1, 1, At, B1); PG8_BAR;
            }
        }
        if constexpr (ALIGN_EPI) { if (wr == 0) PG8_BAR; }
        if constexpr (!Epi::AFTER_DRAIN) { E(acc, cur, wr, wc, fr, fq); S.done(cur); }
        if (!has_next) break;
#pragma unroll
        for (int a = 0; a < 2; ++a)
#pragma unroll
            for (int b = 0; b < 2; ++b)
#pragma unroll
                for (int m = 0; m < 4; ++m)
#pragma unroll
                    for (int n = 0; n < 2; ++n) acc[a][b][m][n] = (f32x4){0.f, 0.f, 0.f, 0.f};
        cur = nxt; cA = nA; cB = nB; ++ui;
        if constexpr (ALIGN_EPI) { if (wr == 1) PG8_BAR; }
    }
    PG8_WAIT_V(0);
    if constexpr (!ALIGN_EPI) { if (wr == 0) PG8_BAR; }
    PG8_BAR;
    if constexpr (Epi::AFTER_DRAIN) { E.fused(acc, cur, wr, wc, fr, fq, lds, wid, lane); S.done(cur); }
#undef PG8_SA
#undef PG8_SB
#undef PG8_STAGE
#undef PG8_LDA
#undef PG8_LDB
#undef PG8_MMA
#undef PG8_WAIT_V
#undef PG8_WAIT_L
#undef PG8_BAR
#undef PG8_SCHED
}
}

#ifndef PG8_SP2
#define PG8_SP2 true
#endif
#ifndef PG8_ALIGN
#define PG8_ALIGN true
#endif
#include <hip/hip_bf16.h>
#include <cmath>
#include <hip/hip_bf16.h>
#include <cmath>
namespace attn_body {
using bf16=__hip_bfloat16;
using bf16x8=__attribute__((ext_vector_type(8)))short;
using s16x4=__attribute__((ext_vector_type(4)))short;
using f32x16=__attribute__((ext_vector_type(16)))float;
using u32x4=__attribute__((ext_vector_type(4)))unsigned;
constexpr int BATCH=4,NHEAD=16,SEQ=4096,D=64,DM=NHEAD*D;
constexpr int NW=8,QBLK=32,QB=QBLK*NW,KVBLK=64,NQB=SEQ/QB;
constexpr int ATTN_PITCH=DM, ATTN_UNIT_ROWS=QB;
__device__ __forceinline__ int crow(int r,int hi){return (r&3)+8*(r>>2)+4*hi;}
#define SBAR() __builtin_amdgcn_sched_barrier(0)
__device__ __forceinline__ void cmask(f32x16&p0,f32x16&p1,int jb,int qrel,int hi){
  const float NEG=-INFINITY; int kb=64*jb+4*hi;
  #pragma unroll
  for(int r=0;r<16;++r){int kv=kb+(r&3)+8*(r>>2); if(kv>qrel)p0[r]=NEG; if(kv+32>qrel)p1[r]=NEG;}
}

constexpr int NSLOT=3, SLOTB=8192;
constexpr int VSLOTB=2*SLOTB;
constexpr int LDS_K=0, LDS_V=NSLOT*SLOTB, LDS_WS=LDS_V+NSLOT*VSLOTB, LDS_OST=LDS_WS+NW*64*4, LDS_Q=LDS_OST+NW*4096, LDS_BYTES=LDS_Q+NW*4096;
constexpr float C2=0.125f*1.4426950408889634f;
__device__ __forceinline__ void glds16(const void*gsrc,unsigned lds_dst){unsigned keep;
  asm volatile("s_mov_b32 %0, m0\n\ts_mov_b32 m0, %2\n\ts_nop 0\n\tglobal_load_lds_dwordx4 %1, off\n\ts_mov_b32 m0, %0":"=&s"(keep):"v"(gsrc),"s"(lds_dst):"memory");}
__device__ __forceinline__ float max3f(float a,float b,float c){float r;asm("v_max3_f32 %0, %1, %2, %3":"=v"(r):"v"(a),"v"(b),"v"(c));return r;}
__device__ __forceinline__ float max2f(float a,float b){float r;asm("v_max_f32_e32 %0, %1, %2":"=v"(r):"v"(a),"v"(b));return r;}
__device__ __forceinline__ float fadd_s(float a,float b){float r;asm("v_add_f32_e32 %0, %1, %2":"=v"(r):"v"(a),"v"(b));return r;}
__device__ __forceinline__ float fsub_s(float a,float b){float r;asm("v_sub_f32_e32 %0, %1, %2":"=v"(r):"v"(a),"v"(b));return r;}
typedef float f32x2_t __attribute__((ext_vector_type(2))); typedef __bf16 bf16x2_t __attribute__((ext_vector_type(2)));
__device__ __forceinline__ unsigned cvtpk_s(float lo,float hi){f32x2_t v={lo,hi};bf16x2_t b=__builtin_convertvector(v,bf16x2_t);return __builtin_bit_cast(unsigned,b);}
#define WAIT_BAR(N) asm volatile("s_waitcnt vmcnt(" #N ") lgkmcnt(0)\n\ts_barrier":::"memory")

__device__ __forceinline__ void qkt(f32x16&p0,f32x16&p1,const char*Kslot,const bf16x8*qr,const f32x16&negm,int r32,int hi){
  const char*kb=Kslot+hi*1024+r32*16;
  #pragma unroll
  for(int d0=0;d0<4;++d0){
    const bf16x8 b0=*reinterpret_cast<const bf16x8*>(kb+d0*2048);
    const bf16x8 b1=*reinterpret_cast<const bf16x8*>(kb+d0*2048+512);
    if(d0==0){p0=__builtin_amdgcn_mfma_f32_32x32x16_bf16(b0,qr[0],negm,0,0,0);p1=__builtin_amdgcn_mfma_f32_32x32x16_bf16(b1,qr[0],negm,0,0,0);}
    else{p0=__builtin_amdgcn_mfma_f32_32x32x16_bf16(b0,qr[d0],p0,0,0,0);p1=__builtin_amdgcn_mfma_f32_32x32x16_bf16(b1,qr[d0],p1,0,0,0);}}
}
typedef __attribute__((address_space(3))) const char* lds_cptr;
typedef short v4i16_t __attribute__((ext_vector_type(4)));
__device__ __forceinline__ void kload8(bf16x8*kf,lds_cptr kp){
  kf[0]=*(const __attribute__((address_space(3))) bf16x8*)(kp);      kf[1]=*(const __attribute__((address_space(3))) bf16x8*)(kp+512);
  kf[2]=*(const __attribute__((address_space(3))) bf16x8*)(kp+2048); kf[3]=*(const __attribute__((address_space(3))) bf16x8*)(kp+2560);
  kf[4]=*(const __attribute__((address_space(3))) bf16x8*)(kp+4096); kf[5]=*(const __attribute__((address_space(3))) bf16x8*)(kp+4608);
  kf[6]=*(const __attribute__((address_space(3))) bf16x8*)(kp+6144); kf[7]=*(const __attribute__((address_space(3))) bf16x8*)(kp+6656);
}
__device__ __forceinline__ void kload2(bf16x8*kf,lds_cptr kp,int j){ kf[2*j]=*(const __attribute__((address_space(3))) bf16x8*)(kp+j*2048); kf[2*j+1]=*(const __attribute__((address_space(3))) bf16x8*)(kp+j*2048+512); }
__device__ __forceinline__ s16x4 vtr(lds_cptr p){ return __builtin_bit_cast(s16x4,__builtin_amdgcn_ds_read_tr16_b64_v4i16((__attribute__((address_space(3))) v4i16_t*)p)); }
__device__ __forceinline__ float rowmax(const f32x16&p0,const f32x16&p1){
  float a=max3f(p0[0],p0[1],p1[0]),b=max3f(p0[2],p0[3],p1[1]);a=max3f(a,p1[2],p1[3]);
  #pragma unroll
  for(int r=4;r<16;r+=4){a=max3f(a,p0[r],p0[r+1]);b=max3f(b,p0[r+2],p0[r+3]);a=max3f(a,p1[r],p1[r+1]);b=max3f(b,p1[r+2],p1[r+3]);}
  const float m=max2f(a,b);
  auto rr=__builtin_amdgcn_permlane32_swap(__float_as_uint(m),__float_as_uint(m),false,false);
  return max2f(__uint_as_float(rr[0]),__uint_as_float(rr[1]));
}
__device__ __forceinline__ void pv(f32x16*o,int vb,bf16x8 pa0,bf16x8 pa1,bf16x8 pa2,bf16x8 pa3){
  #pragma unroll
  for(int d0=0;d0<4;++d0){s16x4 lo[4],hi[4];
    #pragma unroll
    for(int ks=0;ks<4;++ks){
      asm volatile("ds_read_b64_tr_b16 %0,%1 offset:%c2":"=&v"(lo[ks]):"v"(vb),"i"(d0*4096+ks*1024):"memory");
      asm volatile("ds_read_b64_tr_b16 %0,%1 offset:%c2":"=&v"(hi[ks]):"v"(vb),"i"(d0*4096+ks*1024+512):"memory");}
    asm volatile("s_waitcnt lgkmcnt(0)":::"memory");SBAR();
    #define PK(k) (bf16x8){lo[k][0],lo[k][1],lo[k][2],lo[k][3],hi[k][0],hi[k][1],hi[k][2],hi[k][3]}
    o[d0]=__builtin_amdgcn_mfma_f32_32x32x16_bf16(pa0,PK(0),o[d0],0,0,0);
    o[d0]=__builtin_amdgcn_mfma_f32_32x32x16_bf16(pa1,PK(1),o[d0],0,0,0);
    o[d0]=__builtin_amdgcn_mfma_f32_32x32x16_bf16(pa2,PK(2),o[d0],0,0,0);
    o[d0]=__builtin_amdgcn_mfma_f32_32x32x16_bf16(pa3,PK(3),o[d0],0,0,0);
    #undef PK
  }
}

#ifndef ATTN_STORE16
#define ATTN_STORE16(p,v) (*(u32x4*)(p)=(v))
#endif
template<int THRL> __device__ __forceinline__ void attn_unit(int b,int h,int vcol,int qb,int t0,float sl2,float mref,const bf16*Q,const bf16*K,const bf16*V,bf16*Ob,int opitch,char*shm,const int wave_s){
  const int tid=fresh_tid(wave_s),lane=tid&63,r32=lane&31,hi=lane>>5; const int wid=__builtin_amdgcn_readfirstlane(tid>>6);
  const long rowbase=(long)b*SEQ; const int q0=qb*QB;
  const bf16*Qw=Q+(rowbase+q0+wid*QBLK)*DM+h*D;
  const bf16*Kh=K+(rowbase+(long)t0*KVBLK)*DM+h*D,*Vh=V+(rowbase+(long)t0*KVBLK)*DM+vcol; const int q0e=q0-t0*KVBLK;
  const unsigned lds0=(unsigned)(uintptr_t)shm;
  float*wsf=(float*)(shm+LDS_WS)+wid*64;
  const bf16*ksrc=Kh+(long)lane*DM+wid*8;
  const bf16*vsrc=Vh+(long)(16*(wid&3)+(lane>>2))*DM+(wid>>2)*32+(lane&3)*8;
  const unsigned kdst=lds0+LDS_K+wid*1024, vdst=lds0+LDS_V+wid*1024;
  #define DMA_K(t,slot) glds16(ksrc+(long)(t)*KVBLK*DM,(unsigned)__builtin_amdgcn_readfirstlane(kdst+(slot)))
  #define DMA_V(t,slot) do{ glds16(vsrc+(long)(t)*KVBLK*DM,(unsigned)__builtin_amdgcn_readfirstlane(vdst+2*(slot))); glds16(vsrc+64+(long)(t)*KVBLK*DM,(unsigned)__builtin_amdgcn_readfirstlane(vdst+8192+2*(slot))); }while(0)
  const int vb0=(int)(lds0+LDS_V)+((lane>>4)&1)*32+(lane&3)*8+(4*hi+((lane&15)>>2))*64;
  const char*Kbase=shm+LDS_K; bf16x8 kf[8];
  const lds_cptr shm3=(lds_cptr)shm; const lds_cptr kp0=shm3+LDS_K+hi*1024+r32*16; const lds_cptr vp0=shm3+LDS_V+((lane>>4)&1)*32+(lane&3)*8+(4*hi+((lane&15)>>2))*64;
  const int NT=(q0+QB)/KVBLK-t0;
  DMA_K(0,0);DMA_V(0,0);DMA_K(1,SLOTB);
  bf16x8 qr[4];
  #pragma unroll
  for(int d0=0;d0<4;++d0)qr[d0]=*reinterpret_cast<const bf16x8*>(&Qw[(long)r32*DM+d0*16+hi*8]);
  const lds_cptr qp0=shm3+LDS_Q+wid*4096+lane*16;
  #pragma unroll
  for(int d0=0;d0<4;++d0)*(__attribute__((address_space(3))) bf16x8*)(const_cast<__attribute__((address_space(3))) char*>(qp0)+d0*1024)=qr[d0];
  #define QLD(d) (*(const __attribute__((address_space(3))) bf16x8*)(qp0+(d)*1024))
  float mhat=0.f,l_reg=0.f;f32x16 o[4];o[0]=f32x16{};o[1]=f32x16{};o[2]=f32x16{};o[3]=f32x16{};
  const int qrel=wid*QBLK+r32;
  const bool chk=(2.f*mref+2.f>(float)THRL);
  #define CMASK(P0,P1,t) do{int jb_=(t)-(NT-4); if(jb_>=0)cmask(P0,P1,jb_,qrel,hi);}while(0)
  #define ALIBI(P0,P1,t) do{ const float b0_=fmaf(sl2,(float)(64*(t)-q0e+4*hi),-mhat), b1_=fmaf(sl2,32.f,b0_); \
    _Pragma("unroll") for(int r=0;r<16;++r){P0[r]=fmaf(sl2,(float)((r&3)+8*(r>>2)),P0[r]+b0_);P1[r]=fmaf(sl2,(float)((r&3)+8*(r>>2)),P1[r]+b1_);} }while(0)
  bool resc=false;
  #define START(P0,P1) do{ const float rm=rowmax(P0,P1); resc=false; \
    { const float dl=__builtin_fmaxf(rm,fmaf(sl2,(float)qrel,-mref)); mhat=fadd_s(mhat,dl);     \
      _Pragma("unroll") for(int r=0;r<16;++r){P0[r]=fsub_s(P0[r],dl);P1[r]=fsub_s(P1[r],dl);} \
      } \
    _Pragma("unroll") for(int r=0;r<16;++r)P0[r]=__builtin_amdgcn_exp2f(P0[r]); }while(0)
  #define RESC() do{ if(resc){ asm volatile("s_waitcnt lgkmcnt(0)":::"memory"); \
      _Pragma("unroll") for(int d_=0;d_<4;++d_) _Pragma("unroll") for(int r=0;r<16;++r)o[d_][r]*=wsf[crow(r,hi)]; } }while(0)
  f32x16 pA0,pA1,pB0,pB1;
  int sl_prev=0,sl_cur=0,sl_next=SLOTB;
  #define ROT() do{sl_prev=sl_cur;sl_cur=sl_next;sl_next=(sl_next==(NSLOT-1)*SLOTB)?0:sl_next+SLOTB;}while(0)
  DMA_K(2,2*SLOTB);
  WAIT_BAR(3);
  qkt(pA0,pA1,Kbase,qr,f32x16{},r32,hi);asm volatile("s_nop 15\n\ts_nop 7":"+v"(pA0),"+v"(pA1));ALIBI(pA0,pA1,0);CMASK(pA0,pA1,0);
  START(pA0,pA1);
  _Pragma("unroll") for(int r=0;r<16;++r)pA1[r]=__builtin_amdgcn_exp2f(pA1[r]);
  WAIT_BAR(0);
  DMA_K(3,0);DMA_V(1,SLOTB);
  ROT();
  kload8(kf,kp0+sl_cur);
  WAIT_BAR(3);
  s16x4 vlo[8],vhi[8]; u32x4 pw0,pw1,pw2,pw3;
  #define PKW(P,B) cvtpk_s(P[B],P[B+1])
  #define PAF(k) __builtin_bit_cast(bf16x8,pw##k)
  #define VFR(i) (bf16x8){vlo[i][0],vlo[i][1],vlo[i][2],vlo[i][3],vhi[i][0],vhi[i][1],vhi[i][2],vhi[i][3]}
  #define PIN(x) asm volatile("":"+v"(x))
  #define MX3(a,b,c) __builtin_fmaxf(__builtin_fmaxf((a),(b)),(c))
  #define GAPA(MF,A0,A1,A2,A3,W0,W1,PW) do{ MF; sacc+=A0; sacc+=A1; sacc+=A2; sacc+=A3; PIN(sacc); W0; W1; PIN(PW); SBAR(); }while(0)
  #define EX(v) __builtin_amdgcn_exp2f(v)
  #define GAPB(MF,X,B) do{ MF; X[B]=EX(X[B]); X[B+1]=EX(X[B+1]); X[B+2]=EX(X[B+2]); X[B+3]=EX(X[B+3]); PIN(X); SBAR(); }while(0)
  #define GAPB2(MF,X,B) do{ MF; X[B]=EX(X[B]); X[B+1]=EX(X[B+1]); PIN(X); SBAR(); }while(0)
  #define VRD2(i) do{ vlo[i]=vtr(vp_+((((i)+8)>>2)*4096+((i)&3)*1024)); vhi[i]=vtr(vp_+((((i)+8)>>2)*4096+((i)&3)*1024+512)); SBAR(); }while(0)
  #define VRD(i) do{ vlo[i]=vtr(vp_+(((i)>>2)*4096+((i)&3)*1024)); vhi[i]=vtr(vp_+(((i)>>2)*4096+((i)&3)*1024+512)); }while(0)
  #define KRD(G,j) do{ if(G){ kload2(kf,kp0+sl_next,j); SBAR(); } }while(0)
  #define STEP(C0,C1,P0,P1,t,GK,GV,GL) do{ SBAR(); \
    const lds_cptr vp_=vp0+2*sl_prev; \
    bf16x8 qa_=QLD(0), qb_=QLD(1); VRD(0); SBAR(); float sacc=(P0[0]+P0[1]); \
    GAPA(C0=__builtin_amdgcn_mfma_f32_32x32x16_bf16(kf[0],qa_,f32x16{},0,0,0), P0[2],P0[3],P0[4],P0[5],     pw0[0]=PKW(P0,0), pw0[1]=PKW(P0,2), pw0); \
    VRD(4); SBAR(); GAPA(C1=__builtin_amdgcn_mfma_f32_32x32x16_bf16(kf[1],qa_,f32x16{},0,0,0), P0[6],P0[7],P0[8],P0[9],     pw0[2]=PKW(P0,4), pw0[3]=PKW(P0,6), pw0); \
    qa_=QLD(2); VRD(1); SBAR(); GAPA(C0=__builtin_amdgcn_mfma_f32_32x32x16_bf16(kf[2],qb_,C0,0,0,0),   P0[10],P0[11],P0[12],P0[13], pw1[0]=PKW(P0,8), pw1[1]=PKW(P0,10), pw1); \
    VRD(5); SBAR(); GAPA(C1=__builtin_amdgcn_mfma_f32_32x32x16_bf16(kf[3],qb_,C1,0,0,0),   P0[14],P0[15],P1[0],P1[1],   pw1[2]=PKW(P0,12),pw1[3]=PKW(P0,14), pw1); \
    qb_=QLD(3); VRD(2); SBAR(); GAPA(C0=__builtin_amdgcn_mfma_f32_32x32x16_bf16(kf[4],qa_,C0,0,0,0),   P1[2],P1[3],P1[4],P1[5],     pw2[0]=PKW(P1,0), pw2[1]=PKW(P1,2), pw2); \
    VRD(6); SBAR(); GAPA(C1=__builtin_amdgcn_mfma_f32_32x32x16_bf16(kf[5],qa_,C1,0,0,0),   P1[6],P1[7],P1[8],P1[9],     pw2[2]=PKW(P1,4), pw2[3]=PKW(P1,6), pw2); \
    VRD(3); SBAR(); GAPA(C0=__builtin_amdgcn_mfma_f32_32x32x16_bf16(kf[6],qb_,C0,0,0,0),   P1[10],P1[11],P1[12],P1[13], pw3[0]=PKW(P1,8), pw3[1]=PKW(P1,10), pw3); \
    VRD(7); SBAR(); GAPA(C1=__builtin_amdgcn_mfma_f32_32x32x16_bf16(kf[7],qb_,C1,0,0,0),   P1[14],P1[15],0.f,0.f,       pw3[2]=PKW(P1,12),pw3[3]=PKW(P1,14), pw3); \
    l_reg+=sacc; \
    if(GK){DMA_K((t)+3,sl_cur);} if(GV){DMA_V((t)+1,sl_next);} \
    ALIBI(C0,C1,t); CMASK(C0,C1,t); \
    resc=false; \
    if(chk){ float a=MX3(C0[0],C0[1],C1[0]),b=MX3(C0[2],C0[3],C1[1]); a=MX3(a,C1[2],C1[3]);     \
      _Pragma("unroll") for(int r=4;r<16;r+=4){a=MX3(a,C0[r],C0[r+1]);b=MX3(b,C0[r+2],C0[r+3]);a=MX3(a,C1[r],C1[r+1]);b=MX3(b,C1[r+2],C1[r+3]);} \
      float rm=__builtin_fmaxf(a,b); { auto rr=__builtin_amdgcn_permlane32_swap(__float_as_uint(rm),__float_as_uint(rm),false,false); rm=__builtin_fmaxf(__uint_as_float(rr[0]),__uint_as_float(rr[1])); } \
      if(__builtin_expect(__any(rm>(float)THRL),0)){ const float dl=__builtin_fmaxf(rm,0.f); mhat+=dl; \
        _Pragma("unroll") for(int r=0;r<16;++r){C0[r]-=dl;C1[r]-=dl;} \
        const float f=__builtin_amdgcn_exp2f(-dl); l_reg*=f; if(hi==0)wsf[r32]=f; resc=true; } } \
    SBAR(); \
    GAPB2(o[0]=__builtin_amdgcn_mfma_f32_32x32x16_bf16(PAF(0),VFR(0),o[0],0,0,0), C0,0); VRD2(0); \
    GAPB2(o[1]=__builtin_amdgcn_mfma_f32_32x32x16_bf16(PAF(0),VFR(4),o[1],0,0,0), C0,2); VRD2(4); \
    KRD(GL,0); GAPB2(o[0]=__builtin_amdgcn_mfma_f32_32x32x16_bf16(PAF(1),VFR(1),o[0],0,0,0), C0,4); VRD2(1); \
    KRD(GL,1); GAPB2(o[1]=__builtin_amdgcn_mfma_f32_32x32x16_bf16(PAF(1),VFR(5),o[1],0,0,0), C0,6); VRD2(5); \
    KRD(GL,2); GAPB2(o[0]=__builtin_amdgcn_mfma_f32_32x32x16_bf16(PAF(2),VFR(2),o[0],0,0,0), C0,8); VRD2(2); \
    KRD(GL,3); GAPB2(o[1]=__builtin_amdgcn_mfma_f32_32x32x16_bf16(PAF(2),VFR(6),o[1],0,0,0), C0,10); VRD2(6); \
    GAPB2(o[0]=__builtin_amdgcn_mfma_f32_32x32x16_bf16(PAF(3),VFR(3),o[0],0,0,0), C0,12); VRD2(3); \
    GAPB2(o[1]=__builtin_amdgcn_mfma_f32_32x32x16_bf16(PAF(3),VFR(7),o[1],0,0,0), C0,14); VRD2(7); \
    GAPB2(o[2]=__builtin_amdgcn_mfma_f32_32x32x16_bf16(PAF(0),VFR(0),o[2],0,0,0), C1,0); \
    GAPB2(o[3]=__builtin_amdgcn_mfma_f32_32x32x16_bf16(PAF(0),VFR(4),o[3],0,0,0), C1,2); \
    GAPB2(o[2]=__builtin_amdgcn_mfma_f32_32x32x16_bf16(PAF(1),VFR(1),o[2],0,0,0), C1,4); \
    GAPB2(o[3]=__builtin_amdgcn_mfma_f32_32x32x16_bf16(PAF(1),VFR(5),o[3],0,0,0), C1,6); \
    GAPB2(o[2]=__builtin_amdgcn_mfma_f32_32x32x16_bf16(PAF(2),VFR(2),o[2],0,0,0), C1,8); \
    GAPB2(o[3]=__builtin_amdgcn_mfma_f32_32x32x16_bf16(PAF(2),VFR(6),o[3],0,0,0), C1,10); \
    GAPB2(o[2]=__builtin_amdgcn_mfma_f32_32x32x16_bf16(PAF(3),VFR(3),o[2],0,0,0), C1,12); \
    GAPB2(o[3]=__builtin_amdgcn_mfma_f32_32x32x16_bf16(PAF(3),VFR(7),o[3],0,0,0), C1,14); \
    }while(0)
  int t=1;
  #undef CMASK
  #define CMASK(P0,P1,t) do{}while(0)
  for(;t+5<NT;t+=2){
    STEP(pB0,pB1,pA0,pA1,t,true,true,true);     WAIT_BAR(3); RESC(); ROT();
    STEP(pA0,pA1,pB0,pB1,t+1,true,true,true);   WAIT_BAR(3); RESC(); ROT();
  }
  #undef CMASK
  #define CMASK(P0,P1,t) do{int jb_=(t)-(NT-4); if(jb_>=0)cmask(P0,P1,jb_,qrel,hi);}while(0)
  #define ENDW(tt) do{ if((tt)+3<NT){WAIT_BAR(3);} else if((tt)+2<NT){WAIT_BAR(2);} else {WAIT_BAR(0);} }while(0)
  for(;t+1<NT;t+=2){
    STEP(pB0,pB1,pA0,pA1,t,(t+3<NT),(t+1<NT),(t+1<NT));       ENDW(t);   RESC(); ROT();
    STEP(pA0,pA1,pB0,pB1,t+1,(t+4<NT),(t+2<NT),(t+2<NT));     ENDW(t+1); RESC(); ROT();
  }
  STEP(pB0,pB1,pA0,pA1,NT-1,false,false,false); RESC();
  { float sacc=pB0[0]+pB0[1]; _Pragma("unroll") for(int r=2;r<16;++r)sacc+=pB0[r]; _Pragma("unroll") for(int r=0;r<16;++r)sacc+=pB1[r]; l_reg+=sacc;
    pw0=(u32x4){PKW(pB0,0),PKW(pB0,2),PKW(pB0,4),PKW(pB0,6)};pw1=(u32x4){PKW(pB0,8),PKW(pB0,10),PKW(pB0,12),PKW(pB0,14)};pw2=(u32x4){PKW(pB1,0),PKW(pB1,2),PKW(pB1,4),PKW(pB1,6)};pw3=(u32x4){PKW(pB1,8),PKW(pB1,10),PKW(pB1,12),PKW(pB1,14)};
    SBAR(); pv(o,vb0+2*sl_cur,PAF(0),PAF(1),PAF(2),PAF(3)); }
  #undef PKW
  #undef PAF
  #undef VFR
  #undef PIN
  #undef MX3
  #undef GAPA
  #undef GAPB
  #undef GAPB2
  #undef VRD2
  #undef EX
  #undef VRD
  #undef KRD
  #undef STEP
  #undef ENDW
  {auto rr=__builtin_amdgcn_permlane32_swap(__float_as_uint(l_reg),__float_as_uint(l_reg),false,false);l_reg=__uint_as_float(rr[0])+__uint_as_float(rr[1]);}
  if(hi==0)wsf[32+r32]=l_reg;asm volatile("s_waitcnt lgkmcnt(0)":::"memory");
  float rli[16];
  #pragma unroll
  for(int r=0;r<16;++r)rli[r]=__builtin_amdgcn_rcpf(wsf[32+crow(r,hi)]);
  bf16*Ow=Ob+(long)(wid*QBLK)*opitch;
  { bf16*stg=(bf16*)(shm+LDS_OST)+wid*2048;
    #pragma unroll
    for(int hf=0;hf<2;++hf){
      #pragma unroll
      for(int r=0;r<16;++r){const int orow=crow(r,hi);
        #pragma unroll
        for(int d0=0;d0<2;++d0)stg[orow*64+d0*32+r32]=__float2bfloat16(o[2*hf+d0][r]*rli[r]);}
      asm volatile("s_waitcnt lgkmcnt(0)":::"memory");
      #pragma unroll
      for(int i=0;i<4;++i){const int row=i*8+(lane>>3),ch=lane&7; const u32x4 v=*(const u32x4*)(stg+row*64+ch*8); ATTN_STORE16(Ow+(long)row*opitch+hf*64+ch*8,v);}
      asm volatile("s_waitcnt lgkmcnt(0)":::"memory"); } }
  asm volatile("s_waitcnt lgkmcnt(0)\n\ts_barrier":::"memory");
  #undef DMA_K
  #undef DMA_V
  #undef QLD
  #undef CMASK
  #undef ALIBI
  #undef START
  #undef RESC
  #undef ROT
}
constexpr int ATTN_LDS_BYTES=LDS_BYTES;
#undef SBAR
#undef WAIT_BAR
}
constexpr int NWAVES = 8, NTHR = 512;
constexpr int BATCH = 4, SEQ = 4096, TT = BATCH * SEQ, DMOD = 1024, FF = 4096, DIN = 8200;
constexpr float EPSN = 1e-6f;
constexpr size_t MiB = 1u << 20;
constexpr size_t WS_WIN = 0, WS_W1T = 0, WS_W2T = 8 * MiB;
constexpr size_t WS_XN = 16 * MiB;
constexpr size_t WS_B0 = 48 * MiB, WS_BSTR = 32 * MiB;
constexpr size_t WS_H = 48 * MiB;
constexpr size_t WS_WAT = 240 * MiB, WS_WMT = 242 * MiB, WS_WOT = 244 * MiB, WS_IF = 246 * MiB, WS_CTL = 247 * MiB, WS_END = 248 * MiB;
constexpr size_t CTL_BYTES = 256 * 1024;
constexpr int RING_BYTES = 131072, LDS_BYTES = 147456, MISC_OFF = LDS_BYTES - 256;

#define LAS __attribute__((address_space(3)))
typedef unsigned short bf16;
typedef unsigned v4u __attribute__((ext_vector_type(4)));
typedef unsigned v2u __attribute__((ext_vector_type(2)));
typedef float f32x4 __attribute__((ext_vector_type(4)));
typedef float f32x16 __attribute__((ext_vector_type(16)));
typedef short bf16x8 __attribute__((ext_vector_type(8)));
typedef short s16x4 __attribute__((ext_vector_type(4)));
__device__ __forceinline__ unsigned f2bf(float f) { unsigned u = __builtin_bit_cast(unsigned, f); return (u + 0x7fffu + ((u >> 16) & 1u)) >> 16; }
__device__ __forceinline__ unsigned pk2(float lo, float hi) { return f2bf(lo) | (f2bf(hi) << 16); }
__device__ __forceinline__ unsigned cvtpk(float lo, float hi) { return pg8::cvt_pk_bf16(lo, hi); }
__device__ __forceinline__ float bflo(unsigned w) { return __uint_as_float(w << 16); }
__device__ __forceinline__ float bfhi(unsigned w) { return __uint_as_float(w & 0xffff0000u); }
__device__ __forceinline__ float wave_sum(float v) {
#pragma unroll
    for (int o = 1; o < 64; o <<= 1) v += sx(v, o);
    return v;
}
__device__ __forceinline__ void transpose_item(const float* W, int ldw, int K, bf16* WT, int nd0, int ns0, int k0, const float* kscale, LAS float* scr, int lane) {
    float tv[32];
#pragma unroll
    for (int i = 0; i < 32; ++i) { const int kk = 2 * i + (lane >> 5); tv[i] = __builtin_nontemporal_load(W + (size_t)(k0 + kk) * ldw + ns0 + (lane & 31)); }
#pragma unroll
    for (int i = 0; i < 32; ++i) { const int kk = 2 * i + (lane >> 5); float v = tv[i]; if (kscale) v *= kscale[k0 + kk]; scr[kk * 33 + (lane & 31)] = v; }
    asm volatile("s_waitcnt lgkmcnt(0)" ::: "memory");
    const int c = lane & 7;
#pragma unroll
    for (int j = 0; j < 4; ++j) { const int n = (lane >> 3) + 8 * j; const LAS float* s = scr + (8 * c) * 33 + n;
        v4u o; o.x = pk2(s[0 * 33], s[1 * 33]); o.y = pk2(s[2 * 33], s[3 * 33]); o.z = pk2(s[4 * 33], s[5 * 33]); o.w = pk2(s[6 * 33], s[7 * 33]);
        *(v4u*)(WT + (size_t)(nd0 + n) * K + k0 + 8 * c) = o; }
    asm volatile("s_waitcnt lgkmcnt(0)" ::: "memory");
}

namespace mls {
constexpr int OFF_QS = 0, OFF_KS = 17408, OFF_KTS = 34816, OFF_VTS = 53248, OFF_PS = 90112, OFF_CS = 99328, OFF_RS = 99584, OFF_QN = 100096, OFF_NV = 100352, OFF_HSQ = 100864, OFF_NG = 102912;
constexpr int QPB = 272, SPB = 144;
#define MFMA32(a, b, c) __builtin_amdgcn_mfma_f32_32x32x16_bf16((a), (b), (c), 0, 0, 0)
__device__ __forceinline__ bf16x8 ld128(LAS const unsigned char* p) { return *(LAS const bf16x8*)p; }
__device__ __forceinline__ float bfe(const v4u& u, int i) { const unsigned w = (i >> 1) == 0 ? u.x : (i >> 1) == 1 ? u.y : (i >> 1) == 2 ? u.z : u.w; return (i & 1) ? bfhi(w) : bflo(w); }

__device__ __forceinline__ float shf(float v, int src) { return __builtin_bit_cast(float, __builtin_amdgcn_ds_bpermute(src << 2, __builtin_bit_cast(int, v))); }
constexpr int OFF_MC = 103936, OFF_M63 = 104192, OFF_G = 104448, OFF_CM = 104704;
#define CH_FRESH() int tid = tid0; asm volatile("" : "+v"(tid)); const int lane = tid & 63, r32 = lane & 31, hi = lane >> 5; (void)r32; (void)hi
constexpr int NSEG = 8, CPS = 64 / NSEG;
constexpr size_t ST_FLOATS = 128 * 256 + 128 + 64;
static_assert(MiB + 16 * (NSEG - 1) * ST_FLOATS * 4 <= 16 * MiB, "chain state scratch must fit the upper half of B3");
template <bool FULL>
__device__ __forceinline__ void chain_run(LAS unsigned char* L, const int tid0, const int wid, const int h, const size_t row0, const int c0, const bf16* QKc, bf16* MV, const bf16* MLO, const f32x4* GS, f32x16 (&acc)[4]) {
    LAS float* CS = (LAS float*)(L + OFF_CS); LAS float* RS = (LAS float*)(L + OFF_RS); LAS float* QN = (LAS float*)(L + OFF_QN);
    LAS float* NV = (LAS float*)(L + OFF_NV); LAS float* HSQ = (LAS float*)(L + OFF_HSQ); LAS float* NG = (LAS float*)(L + OFF_NG);
    LAS float* MC = (LAS float*)(L + OFF_MC); LAS float* M63A = (LAS float*)(L + OFF_M63);
    const bool isK = wid < 4;
    v4u pq[4], pv[4]; f32x4 gsv;
#define CH_PREFETCH(ci) do { CH_FRESH(); int c_ = (ci); asm volatile("" : "+s"(c_)); const size_t rb_ = row0 + (size_t)(c0 + c_) * 64; \
        const char* qb_ = (const char*)QKc + rb_ * 2048; const char* vb_ = (const char*)MV + rb_ * 2048; \
        if (isK) { const unsigned koff = (unsigned)(((4 * ((tid >> 4) & 15)) * 1024 + 512 + h * 128 + 8 * (tid & 15)) * 2); \
            _Pragma("unroll") for (int j = 0; j < 4; ++j) pq[j] = *(const v4u*)(qb_ + koff + j * 2048); } \
        else if (FULL) { const unsigned koff = (unsigned)(((((tid - 256) >> 2)) * 1024 + h * 128 + 32 * ((tid - 256) & 3)) * 2); \
            _Pragma("unroll") for (int j = 0; j < 4; ++j) pq[j] = *(const v4u*)(qb_ + koff + j * 16); } \
        { const unsigned voff = (unsigned)(((4 * (tid >> 5)) * 1024 + h * 256 + 8 * (tid & 31)) * 2); \
            _Pragma("unroll") for (int j = 0; j < 4; ++j) pv[j] = *(const v4u*)(vb_ + voff + j * 2048); } \
        gsv = GS[c_ * 64 + lane]; } while (0)
    CH_PREFETCH(0);
#pragma unroll 1
    for (int c = 0; c < CPS; ++c) {
        int cq = c; asm volatile("" : "+s"(cq)); const size_t rb = row0 + (size_t)(c0 + cq) * 64;
        float Mt, wint, flr, decay;
        {
            CH_FRESH();
            const float mc = MC[cq], m63 = M63A[cq];
            const float bb = gsv[0], cc = gsv[1], cm = gsv[2];
            Mt = fmaxf(mc, cm);
            wint = __expf(mc - Mt);
            flr = __expf(-(bb + Mt));
            const float wsc = __expf(cc - m63);
            decay = __expf(mc - m63);
            if (FULL && wid == 0) CS[lane] = cc;
            if (isK) {
                const int kcg = tid & 15, ktg = (tid >> 4) & 15;
                float w4[4];
#pragma unroll
                for (int j = 0; j < 4; ++j) { w4[j] = shf(wsc, 4 * ktg + j); if (FULL) *(LAS v4u*)(L + OFF_KS + (4 * ktg + j) * QPB + kcg * 16) = pq[j]; }
#pragma unroll
                for (int i = 0; i < 8; ++i) { v2u o; o.x = cvtpk(bfe(pq[0], i) * w4[0], bfe(pq[1], i) * w4[1]); o.y = cvtpk(bfe(pq[2], i) * w4[2], bfe(pq[3], i) * w4[3]);
                    *(LAS v2u*)(L + OFF_KTS + (8 * kcg + i) * SPB + ktg * 8) = o; }
            } else if (FULL) {
                const int qt = (tid - 256) >> 2, qdg = (tid - 256) & 3;
#pragma unroll
                for (int j = 0; j < 4; ++j) *(LAS v4u*)(L + OFF_QS + qt * QPB + (32 * qdg + 8 * j) * 2) = pq[j];
            }
            const int vdg = tid & 31, vsg = tid >> 5;
#pragma unroll
            for (int i = 0; i < 8; ++i) { v2u o;
                const unsigned a0 = (i >> 1) == 0 ? pv[0].x : (i >> 1) == 1 ? pv[0].y : (i >> 1) == 2 ? pv[0].z : pv[0].w;
                const unsigned a1 = (i >> 1) == 0 ? pv[1].x : (i >> 1) == 1 ? pv[1].y : (i >> 1) == 2 ? pv[1].z : pv[1].w;
                const unsigned a2 = (i >> 1) == 0 ? pv[2].x : (i >> 1) == 1 ? pv[2].y : (i >> 1) == 2 ? pv[2].z : pv[2].w;
                const unsigned a3 = (i >> 1) == 0 ? pv[3].x : (i >> 1) == 1 ? pv[3].y : (i >> 1) == 2 ? pv[3].z : pv[3].w;
                if (i & 1) { o.x = (a0 >> 16) | (a1 & 0xffff0000u); o.y = (a2 >> 16) | (a3 & 0xffff0000u); }
                else       { o.x = (a0 & 0xffffu) | (a1 << 16);     o.y = (a2 & 0xffffu) | (a3 << 16); }
                *(LAS v2u*)(L + OFF_VTS + (8 * vdg + i) * SPB + vsg * 8) = o; }
        }
        __syncthreads();
        if (c + 1 < CPS) CH_PREFETCH(c + 1);
        v2u op[2][4];
        f32x16 nT[2];
        if (FULL) {
            {   CH_FRESH();
                const unsigned ooff = (unsigned)((r32 * 1024 + h * 256 + 32 * wid + 4 * hi) * 2);
#pragma unroll
                for (int tt = 0; tt < 2; ++tt)
#pragma unroll
                    for (int j = 0; j < 4; ++j) op[tt][j] = *(const v2u*)((const char*)MLO + (rb * 2048 + tt * 65536) + ooff + j * 16);
            }
            nT[0] = f32x16{}; nT[1] = f32x16{};
            {
                CH_FRESH();
                if (wid < 4) {
                    const int st = wid & 1, tt = wid >> 1, t = 32 * tt + r32;
                    if (st == 1 && tt == 0) {
#pragma unroll
                        for (int j = 0; j < 4; ++j) *(LAS v2u*)(L + OFF_PS + t * SPB + (32 + 8 * j + 4 * hi) * 2) = (v2u){0u, 0u};
                        if (hi == 0) RS[64 + t] = 0.f;
                    } else {
                        f32x16 sT = f32x16{};
                        LAS const unsigned char* kp = L + OFF_KS + (32 * st + r32) * QPB + 16 * hi; LAS const unsigned char* qp = L + OFF_QS + t * QPB + 16 * hi;
#pragma unroll
                        for (int half = 0; half < 2; ++half) { bf16x8 ka[4], qa[4];
#pragma unroll
                            for (int kk = 0; kk < 4; ++kk) { ka[kk] = ld128(kp + (4 * half + kk) * 32); qa[kk] = ld128(qp + (4 * half + kk) * 32); }
#pragma unroll
                            for (int kk = 0; kk < 4; ++kk) sT = MFMA32(ka[kk], qa[kk], sT); }
                        const float Mtl = shf(Mt, t);
                        float sum = 0.f;
#pragma unroll
                        for (int j = 0; j < 4; ++j) { const int s0 = 32 * st + 8 * j + 4 * hi; const f32x4 c4 = *(LAS const f32x4*)(CS + s0); float v[4];
#pragma unroll
                            for (int i = 0; i < 4; ++i) { const float e = __expf(fminf(c4[i] - Mtl, 0.f)); v[i] = (s0 + i <= t) ? sT[4 * j + i] * e : 0.f; sum += v[i]; }
                            v2u o; o.x = cvtpk(v[0], v[1]); o.y = cvtpk(v[2], v[3]); *(LAS v2u*)(L + OFF_PS + t * SPB + s0 * 2) = o; }
                        sum += shf(sum, lane ^ 32);
                        if (hi == 0) RS[64 * st + t] = sum;
                    }
                }
#pragma unroll
                for (int Td = 0; Td < 4; ++Td) {
                    v2u qv[2][2][2];
#pragma unroll
                    for (int jj = 0; jj < 2; ++jj)
#pragma unroll
                        for (int tt = 0; tt < 2; ++tt) { LAS const unsigned char* qp = L + OFF_QS + (32 * tt + r32) * QPB + (32 * Td + 16 * jj + 4 * hi) * 2;
                            qv[jj][tt][0] = *(LAS const v2u*)qp; qv[jj][tt][1] = *(LAS const v2u*)(qp + 16); }
#pragma unroll
                    for (int jj = 0; jj < 2; ++jj) {
                        v4u aw; aw.x = cvtpk(acc[Td][8 * jj + 0], acc[Td][8 * jj + 1]); aw.y = cvtpk(acc[Td][8 * jj + 2], acc[Td][8 * jj + 3]); aw.z = cvtpk(acc[Td][8 * jj + 4], acc[Td][8 * jj + 5]); aw.w = cvtpk(acc[Td][8 * jj + 6], acc[Td][8 * jj + 7]);
                        const bf16x8 af = __builtin_bit_cast(bf16x8, aw);
#pragma unroll
                        for (int tt = 0; tt < 2; ++tt) { const v4u qw = {qv[jj][tt][0].x, qv[jj][tt][0].y, qv[jj][tt][1].x, qv[jj][tt][1].y};
                            nT[tt] = MFMA32(af, __builtin_bit_cast(bf16x8, qw), nT[tt]); }
                    }
                }
                { const int t = 8 * wid + (lane >> 3), dp = lane & 7; LAS const unsigned char* qp = L + OFF_QS + t * QPB + dp * 32;
                    const v4u qa = *(LAS const v4u*)qp, qb = *(LAS const v4u*)(qp + 16); float d = 0.f;
#pragma unroll
                    for (int i = 0; i < 4; ++i) { const f32x4 n4 = *(LAS const f32x4*)(NV + 16 * dp + 4 * i); const v4u& q = (i < 2) ? qa : qb; const unsigned w0 = (i & 1) ? q.z : q.x, w1 = (i & 1) ? q.w : q.y;
                        d += bflo(w0) * n4[0] + bfhi(w0) * n4[1] + bflo(w1) * n4[2] + bfhi(w1) * n4[3]; }
                    d += shf(d, lane ^ 1); d += shf(d, lane ^ 2); d += shf(d, lane ^ 4);
                    if (dp == 0) QN[t] = d; }
            }
            __syncthreads();
        }
        {
            CH_FRESH();
            bf16x8 vf[4], pb[2][4], ka[4];
#pragma unroll
            for (int kk = 0; kk < 4; ++kk) vf[kk] = ld128(L + OFF_VTS + (32 * wid + r32) * SPB + (16 * kk + 8 * hi) * 2);
            if (FULL) {
#pragma unroll
                for (int tt = 0; tt < 2; ++tt)
#pragma unroll
                    for (int kk = 0; kk < 4; ++kk) if (tt == 1 || kk < 2) pb[tt][kk] = ld128(L + OFF_PS + (32 * tt + r32) * SPB + (16 * kk + 8 * hi) * 2);
            }
#pragma unroll
            for (int kk = 0; kk < 4; ++kk) ka[kk] = ld128(L + OFF_KTS + r32 * SPB + (16 * kk + 8 * hi) * 2);
            float dn[2];
            if (FULL) {
#pragma unroll
                for (int tt = 0; tt < 2; ++tt) { const int t = 32 * tt + r32; const float wl = shf(wint, t), fl = shf(flr, t);
                    const float den = wl * QN[t] + RS[t] + RS[64 + t]; dn[tt] = 1.f / fmaxf(fabsf(den), fl);
#pragma unroll
                    for (int r = 0; r < 16; ++r) nT[tt][r] *= wl; }
#pragma unroll
                for (int tt = 0; tt < 2; ++tt)
#pragma unroll
                    for (int kk = 0; kk < 4; ++kk) if (tt == 1 || kk < 2) nT[tt] = MFMA32(vf[kk], pb[tt][kk], nT[tt]);
            }
#pragma unroll
            for (int Td = 0; Td < 4; ++Td) {
#pragma unroll
                for (int r = 0; r < 16; ++r) acc[Td][r] *= decay;
#pragma unroll
                for (int kk = 0; kk < 4; ++kk) acc[Td] = MFMA32(ka[kk], vf[kk], acc[Td]);
                if (Td < 3) {
#pragma unroll
                    for (int kk = 0; kk < 4; ++kk) ka[kk] = ld128(L + OFF_KTS + (32 * (Td + 1) + r32) * SPB + (16 * kk + 8 * hi) * 2);
                }
            }
            if (FULL) {
#pragma unroll
                for (int tt = 0; tt < 2; ++tt) { const int t = 32 * tt + r32; float hs = 0.f;
#pragma unroll
                    for (int r = 0; r < 16; ++r) { nT[tt][r] *= dn[tt]; hs += nT[tt][r] * nT[tt][r]; }
                    hs += shf(hs, lane ^ 32);
                    if (hi == 0) HSQ[wid * 64 + t] = hs; }
            }
            if (tid < 128) { float s = 0.f;
#pragma unroll
                for (int i = 0; i < 8; ++i) { const v4u k8 = *(LAS const v4u*)(L + OFF_KTS + tid * SPB + i * 16); s += (bflo(k8.x) + bfhi(k8.x)) + (bflo(k8.y) + bfhi(k8.y)) + (bflo(k8.z) + bfhi(k8.z)) + (bflo(k8.w) + bfhi(k8.w)); }
                NV[tid] = decay * NV[tid] + s; }
        }
        __syncthreads();
        if (FULL) {
            CH_FRESH();
            const unsigned ooff = (unsigned)((r32 * 1024 + h * 256 + 32 * wid + 4 * hi) * 2);
#pragma unroll
            for (int tt = 0; tt < 2; ++tt) { const int t = 32 * tt + r32; float hsum = 0.f;
#pragma unroll
                for (int w = 0; w < 8; ++w) hsum += HSQ[w * 64 + t];
                const float rstd = __builtin_amdgcn_rsqf(hsum * (1.f / 256.f) + EPSN);
#pragma unroll
                for (int j = 0; j < 4; ++j) { const v2u ow = op[tt][j];
                    const float y0 = nT[tt][4 * j + 0] * rstd * bflo(ow.x), y1 = nT[tt][4 * j + 1] * rstd * bfhi(ow.x);
                    const float y2 = nT[tt][4 * j + 2] * rstd * bflo(ow.y), y3 = nT[tt][4 * j + 3] * rstd * bfhi(ow.y);
                    v2u o; o.x = cvtpk(y0, y1); o.y = cvtpk(y2, y3);
                    *(v2u*)((char*)MV + (rb * 2048 + tt * 65536) + ooff + j * 16) = o; } }
        }
    }
    __syncthreads();
#undef CH_PREFETCH
}

__device__ __forceinline__ void chain(LAS unsigned char* L, int b, int h, int seg, const bf16* QKc, bf16* MV, const bf16* MLO, const float* IFg, const float* ng, f32x4* GSall, float* STbh, unsigned* flags, const int wid) {
    const int tid0 = fresh_tid(wid);
    const size_t row0 = (size_t)b * SEQ; const int c0 = seg * CPS;
    LAS float* NV = (LAS float*)(L + OFF_NV); LAS float* NG = (LAS float*)(L + OFF_NG);
    LAS float* MC = (LAS float*)(L + OFF_MC); LAS float* M63A = (LAS float*)(L + OFF_M63); LAS float* GG = (LAS float*)(L + OFF_G); LAS float* CM63 = (LAS float*)(L + OFF_CM);
    f32x4* GS = GSall + (size_t)c0 * 64;
    if (tid0 < 128) NV[tid0] = 0.f;
    if (tid0 < 256) NG[tid0] = ng[h * 256 + tid0];
    {
        CH_FRESH();
        const int c = wid;
        const size_t tok = row0 + (size_t)(c0 + c) * 64 + lane;
        const float gi = IFg[tok * 8 + h], gf = IFg[tok * 8 + 4 + h];
        const float lf = fminf(gf, 0.f) - log1pf(__expf(-fabsf(gf)));
        float bb = lf;
#pragma unroll
        for (int o = 1; o < 64; o <<= 1) { const float v = shf(bb, lane - o); if (lane >= o) bb += v; }
        const float cc = gi - bb;
        float cm = cc;
#pragma unroll
        for (int o = 1; o < 64; o <<= 1) { const float v = shf(cm, lane - o); if (lane >= o) cm = fmaxf(cm, v); }
        GS[c * 64 + lane] = (f32x4){bb, cc, cm, 0.f};
        if (lane == 63) { GG[c] = bb; CM63[c] = cm; }
        asm volatile("s_waitcnt vmcnt(0)" ::: "memory");
        __syncthreads();
    }
    f32x16 acc[4];
#pragma unroll
    for (int i = 0; i < 4; ++i) acc[i] = f32x16{};
    float* STme = STbh + (size_t)seg * ST_FLOATS;
    if (seg < NSEG - 1) {
        { CH_FRESH(); if (tid == 0) { float m = 0.f, gs = 0.f;
            for (int c = 0; c < CPS; ++c) { MC[c] = m; const float m63 = fmaxf(m, CM63[c]); M63A[c] = m63; m = GG[c] + m63; gs += GG[c]; }
            STme[128 * 256 + 128] = m; STme[128 * 256 + 129] = gs; } }
        __syncthreads();
        chain_run<false>(L, tid0, wid, h, row0, c0, QKc, MV, MLO, GS, acc);
        { CH_FRESH();
#pragma unroll
            for (int Td = 0; Td < 4; ++Td)
#pragma unroll
                for (int r = 0; r < 16; ++r) STme[((wid * 4 + Td) * 16 + r) * 64 + lane] = acc[Td][r];
            if (tid < 128) STme[128 * 256 + tid] = NV[tid];
            asm volatile("s_waitcnt vmcnt(0)" ::: "memory");
            __syncthreads();
            if (tid == 0) { __builtin_amdgcn_fence(__ATOMIC_RELEASE, "agent"); asm volatile("s_waitcnt vmcnt(0)" ::: "memory"); __hip_atomic_store(flags + 16 * seg, 1u, __ATOMIC_RELAXED, __HIP_MEMORY_SCOPE_AGENT); }
        }
    }
    float m0 = 0.f;
    {   CH_FRESH();
        if (seg > 0) {
            if (tid == 0) {
                for (int j = 0; j < seg; ++j) { unsigned sp = 0; while (__hip_atomic_load(flags + 16 * j, __ATOMIC_RELAXED, __HIP_MEMORY_SCOPE_AGENT) == 0u && ++sp < (1u << 22)) __builtin_amdgcn_s_sleep(2); }
                __builtin_amdgcn_fence(__ATOMIC_ACQUIRE, "agent"); asm volatile("s_waitcnt vmcnt(0)" ::: "memory");
            }
            __syncthreads();
        }
#pragma unroll
        for (int i = 0; i < 4; ++i) acc[i] = f32x16{};
        float nreg = 0.f;
#pragma unroll 1
        for (int j = 0; j < seg; ++j) { const float* Sj = STbh + (size_t)j * ST_FLOATS;
            const float ml = __builtin_nontemporal_load(Sj + 128 * 256 + 128), gsum = __builtin_nontemporal_load(Sj + 128 * 256 + 129);
            const float mn = fmaxf(gsum + m0, ml); const float fa = __expf(gsum + m0 - mn), fb = __expf(ml - mn);
#pragma unroll
            for (int Td = 0; Td < 4; ++Td)
#pragma unroll
                for (int r = 0; r < 16; ++r) acc[Td][r] = fa * acc[Td][r] + fb * Sj[((wid * 4 + Td) * 16 + r) * 64 + lane];
            if (tid < 128) nreg = fa * nreg + fb * Sj[128 * 256 + tid];
            m0 = mn; }
        __syncthreads();
        if (tid < 128) NV[tid] = nreg;
        if (tid == 0) { float m = m0;
            for (int c = 0; c < CPS; ++c) { MC[c] = m; const float m63 = fmaxf(m, CM63[c]); M63A[c] = m63; m = GG[c] + m63; } }
        __syncthreads();
    }
    chain_run<true>(L, tid0, wid, h, row0, c0, QKc, MV, MLO, GS, acc);
#undef CH_FRESH
}
}
#define RLX_AGENT __ATOMIC_RELAXED, __HIP_MEMORY_SCOPE_AGENT
#define LDS_WAIT() asm volatile("s_waitcnt lgkmcnt(0)" ::: "memory")
#define VM_WAIT() asm volatile("s_waitcnt vmcnt(0)" ::: "memory")
#define XB_TMO      128
#define XB_XCNT(j)  (256  + 64 * (j))
#define XB_XSUB(j)  (1280 + 64 * (j))
#define XB_XGEN(j)  (2304 + 64 * (j))
#define XB_TOP      3328
#define XB_TOPGEN   3392
#define XCD_BAR_WORDS 3456
#define XB_SPIN_CAP (1u << 18)

__device__ __forceinline__ unsigned xb_ld(unsigned* p)              { return __hip_atomic_load(p, __ATOMIC_RELAXED, __HIP_MEMORY_SCOPE_AGENT); }
__device__ __forceinline__ unsigned xb_add(unsigned* p, unsigned v) { return __hip_atomic_fetch_add(p, v, __ATOMIC_RELAXED, __HIP_MEMORY_SCOPE_AGENT); }
__device__ __forceinline__ unsigned xb_xcc_id() { return (unsigned)__builtin_amdgcn_s_getreg((3 << 11) | 20) & 0xFu; }
#define XB_SPIN(cond, bar) do { unsigned _sp = 0; while (cond) { __builtin_amdgcn_s_sleep(1); \
    if ((++_sp & 255u) == 0u) { if (xb_ld(&(bar)[XB_TMO])) break; if (_sp > XB_SPIN_CAP) { atomicAdd(&(bar)[XB_TMO], 1u); break; } } } } while (0)

struct XcdBarrier {
    unsigned* bar; unsigned x;
    volatile LAS unsigned* st;
};

__device__ __forceinline__ XcdBarrier xcd_barrier_post(unsigned* bar, volatile LAS unsigned* st) {
    XcdBarrier b; b.bar = bar; b.x = xb_xcc_id(); b.st = st;
    if (threadIdx.x == 0) (void)xb_add(&bar[XB_XCNT(b.x)], 1u);
    return b;
}
__device__ __forceinline__ void xcd_barrier_complete(unsigned* bar, unsigned x, unsigned& nloc, unsigned& nx) {
    const unsigned G = gridDim.x * gridDim.y * gridDim.z;
    unsigned sum, cnt, mine, sp = 0u;
    for (;;) {
        sum = 0u; cnt = 0u; mine = 0u;
#pragma unroll
        for (unsigned j = 0; j < 16; ++j) { const unsigned c = xb_ld(&bar[XB_XCNT(j)]); sum += c; cnt += (c > 0u) ? 1u : 0u; mine = (j == x) ? c : mine; }
        if (sum == G) break;
        __builtin_amdgcn_s_sleep(1);
        if ((++sp & 255u) == 0u) { if (xb_ld(&bar[XB_TMO])) break; if (sp > XB_SPIN_CAP) { atomicAdd(&bar[XB_TMO], 1u); break; } }
    }
    nloc = mine > 0u ? mine : 1u; nx = cnt > 0u ? cnt : 1u;
}

__device__ __forceinline__ void xcd_barrier(const XcdBarrier& b) {
    asm volatile("s_waitcnt vmcnt(0)" ::: "memory");
    __syncthreads();
    if (threadIdx.x == 0) {
        unsigned* bar = b.bar;
        __builtin_amdgcn_s_waitcnt(0);
        unsigned nloc = b.st[0], nx = b.st[1];
        if (nloc == 0u) { xcd_barrier_complete(bar, b.x, nloc, nx); b.st[0] = nloc; b.st[1] = nx; }
        const unsigned old = xb_add(&bar[XB_XSUB(b.x)], 1u);
        const unsigned gen = old / nloc;
        if (old + 1u == (gen + 1u) * nloc) {
            __builtin_amdgcn_fence(__ATOMIC_RELEASE, "agent");
            asm volatile("s_waitcnt vmcnt(0)" ::: "memory");
            const unsigned og = xb_add(&bar[XB_TOP], 1u);
            const unsigned tg = og / nx;
            if (og + 1u == (tg + 1u) * nx) xb_add(&bar[XB_TOPGEN], 1u);
            else XB_SPIN(xb_ld(&bar[XB_TOPGEN]) == tg, bar);
            __builtin_amdgcn_fence(__ATOMIC_ACQUIRE, "agent");
            xb_add(&bar[XB_XGEN(b.x)], 1u);
            asm volatile("s_waitcnt vmcnt(0)" ::: "memory");
        } else {
            XB_SPIN(xb_ld(&bar[XB_XGEN(b.x)]) == gen, bar);
            __builtin_amdgcn_fence(__ATOMIC_ACQUIRE, "agent");
            asm volatile("s_waitcnt vmcnt(0)" ::: "memory");
        }
    }
    __syncthreads();
}

__device__ const unsigned short ATT_ORDER[512] = {484,492,500,508,485,493,501,509,486,494,502,510,487,495,503,511,452,460,468,476,453,461,469,477,454,462,470,478,455,463,471,479,420,428,436,444,421,429,437,445,422,430,438,446,423,431,439,447,388,396,404,412,389,397,405,413,390,398,406,414,391,399,407,415,356,364,372,380,357,365,373,381,358,366,374,382,359,367,375,383,324,332,340,348,325,333,341,349,326,334,342,350,327,335,343,351,292,300,308,316,293,301,309,317,294,302,310,318,295,303,311,319,483,491,499,507,451,459,467,475,419,427,435,443,387,395,403,411,355,363,371,379,323,331,339,347,291,299,307,315,259,267,275,283,260,268,276,284,261,269,277,285,262,270,278,286,263,271,279,287,227,235,243,251,228,236,244,252,229,237,245,253,230,238,246,254,231,239,247,255,195,203,211,219,196,204,212,220,197,205,213,221,198,206,214,222,199,207,215,223,163,171,179,187,164,172,180,188,165,173,181,189,166,174,182,190,167,175,183,191,482,490,498,506,450,458,466,474,418,426,434,442,386,394,402,410,354,362,370,378,322,330,338,346,290,298,306,314,258,266,274,282,226,234,242,250,194,202,210,218,162,170,178,186,130,138,146,154,131,139,147,155,132,140,148,156,133,141,149,157,134,142,150,158,135,143,151,159,98,106,114,122,99,107,115,123,100,108,116,124,101,109,117,125,102,110,118,126,103,111,119,127,481,489,497,505,449,457,465,473,417,425,433,441,385,393,401,409,353,361,369,377,321,329,337,345,289,297,305,313,257,265,273,281,225,233,241,249,193,201,209,217,161,169,177,185,129,137,145,153,97,105,113,121,65,73,81,89,66,74,82,90,67,75,83,91,68,76,84,92,69,77,85,93,70,78,86,94,71,79,87,95,480,488,496,504,448,456,464,472,416,424,432,440,384,392,400,408,352,360,368,376,320,328,336,344,288,296,304,312,256,264,272,280,224,232,240,248,192,200,208,216,160,168,176,184,128,136,144,152,96,104,112,120,64,72,80,88,32,40,48,56,33,41,49,57,34,42,50,58,35,43,51,59,36,44,52,60,37,45,53,61,38,46,54,62,39,47,55,63,0,8,16,24,1,9,17,25,2,10,18,26,3,11,19,27,4,12,20,28,5,13,21,29,6,14,22,30,7,15,23,31};
struct Args { const float* in[17]; float* out; unsigned char* ws; };
enum { I_X = 0, I_NMIX, I_WIN, I_BGATES, I_CONVW, I_CONVB, I_LAM, I_DANG, I_MLNG, I_BMERGE, I_WA, I_WM, I_WOUT, I_NMLP, I_WFF1, I_WFF2, I_NFIN };

__global__ void __launch_bounds__(NTHR, 2) mk_fwd(Args a) {
    extern __shared__ __attribute__((aligned(16))) unsigned char lds[];
    cg::grid_group grid = cg::this_grid();
    LAS unsigned char* L = (LAS unsigned char*)lds;
    volatile LAS unsigned* MISC = (volatile LAS unsigned*)(L + MISC_OFF);
    const int wave = __builtin_amdgcn_readfirstlane(threadIdx.x >> 6);
    const int G = gridDim.x, bx = blockIdx.x;
    const int gw = bx * NWAVES + wave, NGW = G * NWAVES;
    unsigned char* ws = a.ws;
    if (threadIdx.x < 32) MISC[threadIdx.x] = 0u;
    __syncthreads();
    XcdBarrier xbar = xcd_barrier_post((unsigned*)(ws + WS_CTL + 16384), MISC + 8);
    const float* x = a.in[I_X];
    bf16* WINT = (bf16*)(ws + WS_WIN); bf16* W1T = (bf16*)(ws + WS_W1T); bf16* W2T = (bf16*)(ws + WS_W2T);
    bf16* XN = (bf16*)(ws + WS_XN); bf16* QKC = XN;
    bf16* B0 = (bf16*)(ws + WS_B0); bf16* B1 = (bf16*)(ws + WS_B0 + WS_BSTR); bf16* B2 = (bf16*)(ws + WS_B0 + 2 * WS_BSTR); bf16* B3 = (bf16*)(ws + WS_B0 + 3 * WS_BSTR);
    bf16* B4 = (bf16*)(ws + WS_B0 + 4 * WS_BSTR); bf16* B5 = (bf16*)(ws + WS_B0 + 5 * WS_BSTR);
    bf16* HB = (bf16*)(ws + WS_H);
    bf16* WAT = (bf16*)(ws + WS_WAT); bf16* WMT = (bf16*)(ws + WS_WMT); bf16* WOT = (bf16*)(ws + WS_WOT);
    float* IFG = (float*)(ws + WS_IF);
    unsigned* CTL = (unsigned*)(ws + WS_CTL); float* RSQ1 = (float*)(ws + WS_CTL + 65536); float* RSQ2 = (float*)(ws + WS_CTL + 131072);
    bf16* GA = (bf16*)a.out; bf16* GM = GA + (size_t)TT * 1024;
    float* OUT = a.out;

    {
        const int tid = fresh_tid(wave), lane = tid & 63;
        LAS float* scr = (LAS float*)(L + wave * 8448);
        LAS float* WIF = (LAS float*)(L + 73728);
        const float* win = a.in[I_WIN];
        for (int i = tid; i < 8192; i += NTHR) WIF[(i & 7) * 1024 + (i >> 3)] = win[(size_t)(i >> 3) * DIN + 5120 + (i & 7)];
        for (int it = gw; it < 16 * 256; it += NGW) { const int kb = it >> 8, nb = it & 255; const int nd0 = 32 * nb, ns0 = nd0 + (nd0 >= 5120 ? 8 : 0);
            transpose_item(win, DIN, 1024, WINT, nd0, ns0, 64 * kb, nullptr, scr, lane); }
        __syncthreads();
        const float* gmix = a.in[I_NMIX]; const float* bg = a.in[I_BGATES];
        f32x4 gv[4];
#pragma unroll
        for (int j = 0; j < 4; ++j) gv[j] = *((const f32x4*)gmix + lane + 64 * j);
        f32x4 nx[4];
        if (gw < TT) {
#pragma unroll
            for (int j = 0; j < 4; ++j) nx[j] = __builtin_nontemporal_load((const f32x4*)(x + (size_t)gw * 1024) + lane + 64 * j); }
        for (int m = gw; m < TT; m += NGW) {
            f32x4 v[4]; float s = 0.f;
#pragma unroll
            for (int j = 0; j < 4; ++j) v[j] = nx[j];
            if (m + NGW < TT) {
#pragma unroll
                for (int j = 0; j < 4; ++j) nx[j] = __builtin_nontemporal_load((const f32x4*)(x + (size_t)(m + NGW) * 1024) + lane + 64 * j); }
#pragma unroll
            for (int j = 0; j < 4; ++j) s += (v[j].x * v[j].x + v[j].y * v[j].y) + (v[j].z * v[j].z + v[j].w * v[j].w);
            const float rstd = 1.f / sqrtf(wave_sum(s) * (1.f / 1024.f) + EPSN);
            float g8[8];
#pragma unroll
            for (int q = 0; q < 8; ++q) g8[q] = 0.f;
            unsigned long long* o8 = (unsigned long long*)(XN + (size_t)m * 1024) + lane;
#pragma unroll
            for (int j = 0; j < 4; ++j) { v[j] = v[j] * rstd * gv[j];
                o8[64 * j] = (unsigned long long)pk2(v[j].x, v[j].y) | ((unsigned long long)pk2(v[j].z, v[j].w) << 32);
#pragma unroll
                for (int q = 0; q < 8; ++q) { const f32x4 w = *(LAS const f32x4*)(WIF + q * 1024 + 256 * j + 4 * lane); g8[q] += (v[j][0] * w[0] + v[j][1] * w[1]) + (v[j][2] * w[2] + v[j][3] * w[3]); } }
            float mine = 0.f;
#pragma unroll
            for (int q = 0; q < 8; ++q) { const float sv = wave_sum(g8[q]); if (lane == q) mine = sv; }
            if (lane < 8) IFG[(size_t)m * 8 + lane] = mine + bg[lane];
        }
    }
    xcd_barrier(xbar);
    if (a.ws == nullptr) grid.sync();

    {
        pg8::Gemm g{XN, WINT, TT, 8192, 1024}; pg8::StaticOrder S; S.init(TT, 8192, G, bx);
        pg8::EpiProj E{B0, GA, (size_t)TT * 1024, a.in[I_BMERGE], attn_body::C2, a.in[I_MLNG], CTL + 12288};
        pg8::gemm_phase<pg8::EpiProj, pg8::StaticOrder, true, true>(L, g, S, E, wave);
    }
    xcd_barrier(xbar);


    {
        const int tid = fresh_tid(wave), lane = tid & 63;
        const float* cw = a.in[I_CONVW]; const float* cb = a.in[I_CONVB];
        const bf16* MLQK = B3;
#pragma unroll 2
        for (int it = bx * NTHR + tid; it < TT * 128; it += G * NTHR) {
            const int row = it >> 7, c0 = (it & 127) * 8, tp = row & (SEQ - 1);
            float acc[8];
            { const f32x4 b0 = *(const f32x4*)(cb + c0), b1 = *(const f32x4*)(cb + c0 + 4); acc[0] = b0[0]; acc[1] = b0[1]; acc[2] = b0[2]; acc[3] = b0[3]; acc[4] = b1[0]; acc[5] = b1[1]; acc[6] = b1[2]; acc[7] = b1[3]; }
#pragma unroll
            for (int j = 0; j < 4; ++j) if (tp - 3 + j >= 0) {
                const v4u u = *(const v4u*)(MLQK + (size_t)(row - 3 + j) * 1024 + c0); const f32x4 w0 = *(const f32x4*)(cw + j * 1024 + c0), w1 = *(const f32x4*)(cw + j * 1024 + c0 + 4);
                acc[0] += w0[0] * bflo(u.x); acc[1] += w0[1] * bfhi(u.x); acc[2] += w0[2] * bflo(u.y); acc[3] += w0[3] * bfhi(u.y);
                acc[4] += w1[0] * bflo(u.z); acc[5] += w1[1] * bfhi(u.z); acc[6] += w1[2] * bflo(u.w); acc[7] += w1[3] * bfhi(u.w); }
            const float sc = (c0 < 512) ? 0.08838834764831845f : 1.f;
#pragma unroll
            for (int i = 0; i < 8; ++i) acc[i] = acc[i] * pg8::sigm(acc[i]) * sc;
            v4u o; o.x = cvtpk(acc[0], acc[1]); o.y = cvtpk(acc[2], acc[3]); o.z = cvtpk(acc[4], acc[5]); o.w = cvtpk(acc[6], acc[7]);
            *(v4u*)(QKC + (size_t)row * 1024 + c0) = o;
        }
    }
    xcd_barrier(xbar);

    {
        const int tid = fresh_tid(wave), lane = tid & 63;
#ifndef NO_CHAIN
        if (bx < 16 * mls::NSEG) { const int bh = bx & 15, seg = bx >> 4; unsigned char* scr = ws + WS_B0 + 3 * WS_BSTR + 16 * MiB;
            mls::chain(L, bh >> 2, bh & 3, seg, QKC, B4, B5, IFG, a.in[I_MLNG], (f32x4*)scr + (size_t)bh * 4096, (float*)(scr + MiB) + (size_t)bh * (mls::NSEG - 1) * mls::ST_FLOATS, CTL + 8192 + bh * 16 * mls::NSEG, wave); }
#endif
        const float* lam = a.in[I_LAM]; float s1 = 0.f, s2 = 0.f;
        for (int k = 0; k < 64; ++k) { s1 += lam[k] * lam[64 + k]; s2 += lam[128 + k] * lam[192 + k]; }
        const float lamf = __expf(s1) - __expf(s2) + 0.2f;
        bf16* OT = B3 + (size_t)bx * (2 * 256 * 64);
        const float* dag = a.in[I_DANG];
        for (;;) {
            if (fresh_tid(wave) == 0) MISC[0] = atomicAdd(CTL, 1u);
            __syncthreads();
            const int item = __builtin_amdgcn_readfirstlane((int)MISC[0]);
            __syncthreads();
            if (item >= 512) break;
            const int code = ATT_ORDER[item];
            const int qb = code >> 5, b = (code >> 3) & 3, h = code & 7;
            const float sl2 = exp2f(-(float)(h + 1)) * 1.4426950408889634f;
            const size_t grow0 = (size_t)b * SEQ + (size_t)qb * 256;
            typedef attn_body::bf16 abf;
#ifndef NO_ATTN
#pragma unroll 1
            for (int m = 0; m < 2; ++m) {
                int t0 = 0; float mref = 0.f;
                { const unsigned* np_ = CTL + 12288 + (b * 16 + 2 * h + m) * 4;
                  const float bq2 = __uint_as_float(__hip_atomic_load(np_ + 0, __ATOMIC_RELAXED, __HIP_MEMORY_SCOPE_AGENT)) + __uint_as_float(__hip_atomic_load(np_ + 1, __ATOMIC_RELAXED, __HIP_MEMORY_SCOPE_AGENT));
                  const float bk2 = __uint_as_float(__hip_atomic_load(np_ + 2, __ATOMIC_RELAXED, __HIP_MEMORY_SCOPE_AGENT)) + __uint_as_float(__hip_atomic_load(np_ + 3, __ATOMIC_RELAXED, __HIP_MEMORY_SCOPE_AGENT));
                  mref = 1.01f * sqrtf(bq2 * bk2);
                  const float dmin = (152.f + 2.02f * sqrtf(bq2 * bk2)) / sl2;
                  const float tf = floorf(((float)(qb * 256 + 1) - dmin) * (1.f / 64.f));
                  int ti = tf > 0.f ? (int)tf : 0; if (ti > 4 * qb) ti = 4 * qb; t0 = __builtin_amdgcn_readfirstlane(ti & ~1); }
                if (m == 0) attn_body::attn_unit<64>(b, 2 * h, h * 128, qb, t0, sl2, mref, (const abf*)B0, (const abf*)B1, (const abf*)B2, (abf*)OT, 128, (char*)lds, wave);
                else        attn_body::attn_unit<64>(b, 2 * h + 1, h * 128, qb, t0, sl2, mref, (const abf*)B0, (const abf*)B1, (const abf*)B2, (abf*)(B0 + grow0 * 1024 + h * 128), 1024, (char*)lds, wave);
            }
#endif
            asm volatile("s_waitcnt vmcnt(0)" ::: "memory");
            __syncthreads();
#ifndef NO_COMB
            {
                const int tidc = fresh_tid(wave); const int row = tidc >> 1, j = tidc & 1; const size_t grow = grow0 + row;
                const bf16* p0 = OT + row * 128 + 64 * j;
                const bf16* p1 = B0 + grow * 1024 + h * 128 + 64 * j;
                float av[64]; float ss = 0.f;
#pragma unroll
                for (int c8 = 0; c8 < 8; ++c8) { const v4u u0 = *(const v4u*)(p0 + 8 * c8), u1 = *(const v4u*)(p1 + 8 * c8);
                    av[8 * c8 + 0] = bflo(u0.x) - lamf * bflo(u1.x); av[8 * c8 + 1] = bfhi(u0.x) - lamf * bfhi(u1.x); av[8 * c8 + 2] = bflo(u0.y) - lamf * bflo(u1.y); av[8 * c8 + 3] = bfhi(u0.y) - lamf * bfhi(u1.y);
                    av[8 * c8 + 4] = bflo(u0.z) - lamf * bflo(u1.z); av[8 * c8 + 5] = bfhi(u0.z) - lamf * bfhi(u1.z); av[8 * c8 + 6] = bflo(u0.w) - lamf * bflo(u1.w); av[8 * c8 + 7] = bfhi(u0.w) - lamf * bfhi(u1.w); }
#pragma unroll
                for (int i = 0; i < 64; ++i) ss += av[i] * av[i];
                ss += sx(ss, 1);
                const float rs = __builtin_amdgcn_rsqf(ss * (1.f / 128.f) + EPSN) * 0.8f;
                bf16* dst = B0 + grow * 1024 + h * 128 + 64 * j; const float* gp = dag + h * 128 + 64 * j;
#pragma unroll
                for (int c8 = 0; c8 < 8; ++c8) { const f32x4 g0 = *(const f32x4*)(gp + 8 * c8), g1 = *(const f32x4*)(gp + 8 * c8 + 4); v4u o;
                    o.x = cvtpk(av[8 * c8 + 0] * rs * g0[0], av[8 * c8 + 1] * rs * g0[1]); o.y = cvtpk(av[8 * c8 + 2] * rs * g0[2], av[8 * c8 + 3] * rs * g0[3]);
                    o.z = cvtpk(av[8 * c8 + 4] * rs * g1[0], av[8 * c8 + 5] * rs * g1[1]); o.w = cvtpk(av[8 * c8 + 6] * rs * g1[2], av[8 * c8 + 7] * rs * g1[3]);
                    *(v4u*)(dst + 8 * c8) = o; }
            }
#endif
            asm volatile("s_waitcnt vmcnt(0)" ::: "memory");
            __syncthreads();
        }
        {
            LAS float* scr = (LAS float*)(L + wave * 8448);
            for (;;) {
                if (tid == 0) MISC[0] = atomicAdd(CTL + 32, 1u);
                __syncthreads();
                const int wi = __builtin_amdgcn_readfirstlane((int)MISC[0]);
                __syncthreads();
                if (wi >= 704) break;
                int r = wi * 8 + wave;
                if (r < 512) { transpose_item(a.in[I_WA], 1024, 1024, WAT, 32 * (r & 31), 32 * (r & 31), 64 * (r >> 5), nullptr, scr, lane); continue; } r -= 512;
                if (r < 512) { transpose_item(a.in[I_WM], 1024, 1024, WMT, 32 * (r & 31), 32 * (r & 31), 64 * (r >> 5), nullptr, scr, lane); continue; } r -= 512;
                if (r < 512) { transpose_item(a.in[I_WOUT], 1024, 1024, WOT, 32 * (r & 31), 32 * (r & 31), 64 * (r >> 5), nullptr, scr, lane); continue; } r -= 512;
                if (r < 2048) { transpose_item(a.in[I_WFF1], 4096, 1024, W1T, 32 * (r & 127), 32 * (r & 127), 64 * (r >> 7), a.in[I_NMLP], scr, lane); continue; } r -= 2048;
                transpose_item(a.in[I_WFF2], 1024, 4096, W2T, 32 * (r & 31), 32 * (r & 31), 64 * (r >> 5), nullptr, scr, lane);
            }
        }
    }
    xcd_barrier(xbar);

    {
        pg8::StaticOrder S; S.init(TT, 1024, G, bx);
        { pg8::Gemm g{B0, WAT, TT, 1024, 1024}; pg8::EpiGate<false> E{GA, nullptr, B1}; pg8::gemm_phase<pg8::EpiGate<false>, pg8::StaticOrder, true, true>(L, g, S, E, wave); }
        { pg8::Gemm g{B4, WMT, TT, 1024, 1024}; pg8::EpiGate<true> E{GM, B1, B2}; pg8::gemm_phase<pg8::EpiGate<true>, pg8::StaticOrder, true, true>(L, g, S, E, wave); }
    }
    xcd_barrier(xbar);

    {
        pg8::Gemm g{B2, WOT, TT, 1024, 1024}; pg8::StaticOrder S; S.init(TT, 1024, G, bx);
        pg8::EpiRes E{x, (G == 256) ? nullptr : OUT, B5, RSQ1};
        pg8::gemm_phase<pg8::EpiRes, pg8::StaticOrder, true, true>(L, g, S, E, wave);
    }
    xcd_barrier(xbar);

    {
        pg8::Gemm g{B5, W1T, TT, 4096, 1024}; pg8::StaticOrder S; S.init(TT, 4096, G, bx);
        pg8::EpiFF1 E{HB, RSQ1, EPSN};
        pg8::gemm_phase<pg8::EpiFF1, pg8::StaticOrder, true, true>(L, g, S, E, wave);
    }
    xcd_barrier(xbar);

    if (G == 256) {
        pg8::Gemm g{HB, W2T, TT, 1024, 4096}; pg8::StaticOrder S; S.init(TT, 1024, G, bx);
        pg8::EpiFinal E{B5, OUT, a.in[I_NFIN], (float*)(ws + WS_CTL + CTL_BYTES), CTL + 49152, EPSN};
        pg8::gemm_phase<pg8::EpiFinal, pg8::StaticOrder, false, true>(L, g, S, E, wave);
    } else {
    {
        pg8::Gemm g{HB, W2T, TT, 1024, 4096}; pg8::StaticOrder S; S.init(TT, 1024, G, bx);
        pg8::EpiRes E{OUT, OUT, nullptr, RSQ2};
        pg8::gemm_phase<pg8::EpiRes, pg8::StaticOrder, true, true>(L, g, S, E, wave);
    }
    xcd_barrier(xbar);

    {
        const int tid = fresh_tid(wave), lane = tid & 63;
        const float* gf = a.in[I_NFIN];
        f32x4 gv[4];
#pragma unroll
        for (int j = 0; j < 4; ++j) gv[j] = *((const f32x4*)gf + lane + 64 * j);
        for (int m = gw; m < TT; m += 2 * NGW) {
            const int m2 = m + NGW; const bool has2 = m2 < TT;
            const float rs = __builtin_amdgcn_rsqf(RSQ2[m] * (1.f / 1024.f) + EPSN), rs2 = has2 ? __builtin_amdgcn_rsqf(RSQ2[m2] * (1.f / 1024.f) + EPSN) : 0.f;
            f32x4* xr = (f32x4*)(OUT + (size_t)m * 1024) + lane; f32x4* xr2 = (f32x4*)(OUT + (size_t)(has2 ? m2 : m) * 1024) + lane;
            f32x4 a0[4], a1[4];
#pragma unroll
            for (int j = 0; j < 4; ++j) { a0[j] = xr[64 * j]; a1[j] = xr2[64 * j]; }
#pragma unroll
            for (int j = 0; j < 4; ++j) { xr[64 * j] = a0[j] * rs * gv[j]; if (has2) xr2[64 * j] = a1[j] * rs2 * gv[j]; }
        }
    }
    }
}

extern "C" void kernel_launch(void* const* d_in, const int* in_sizes, int n_in, void* d_out, int out_size, void* d_ws, size_t ws_size, hipStream_t stream) {
    static int grid = 0;
    if (grid == 0) {
        if (n_in != 17 || out_size != TT * 1024 || ws_size < WS_END) { fprintf(stderr, "kernel_launch: unexpected shapes (n_in %d, out %d, ws %zu)\n", n_in, out_size, ws_size); grid = -1; return; }
        int dev = 0, cus = 0, per_cu = 0;
        hipGetDevice(&dev); hipDeviceGetAttribute(&cus, hipDeviceAttributeMultiprocessorCount, dev);
        if (hipFuncSetAttribute((const void*)mk_fwd, hipFuncAttributeMaxDynamicSharedMemorySize, LDS_BYTES) != hipSuccess) { fprintf(stderr, "kernel_launch: hipFuncSetAttribute failed\n"); grid = -1; return; }
        if (hipOccupancyMaxActiveBlocksPerMultiprocessor(&per_cu, (const void*)mk_fwd, NTHR, LDS_BYTES) != hipSuccess || per_cu < 1) { fprintf(stderr, "kernel_launch: occupancy query gave %d\n", per_cu); per_cu = 1; }
        (void)hipGetLastError();
        grid = cus * per_cu;
    }
    if (grid < 0) return;
    hipMemsetAsync((char*)d_ws + WS_CTL, 0, CTL_BYTES, stream);
    Args a{};
    for (int i = 0; i < 17; ++i) a.in[i] = (const float*)d_in[i];
    a.out = (float*)d_out; a.ws = (unsigned char*)d_ws;
    void* args[] = {&a};
    hipError_t e = hipLaunchCooperativeKernel((const void*)mk_fwd, dim3(grid), dim3(NTHR), args, LDS_BYTES, stream);
    if (e != hipSuccess) fprintf(stderr, "kernel_launch: cooperative launch failed: %s (grid %d)\n", hipGetErrorString(e), grid);
}
```
